# Optimizing an MI355X kernel written in HIP

```python
import math
import jax, jax.numpy as jnp
from jax import lax
import numpy as np

D_MODEL = 1024
BATCH = 4
SEQ = 8192
DEPTH = 2

GRID_W = 64
CTX_LEN = 256
HEAD_DIM = 64
NA_HEADS = 4
NA_ROWS = 8
NA_COLS = 16
MLA_HEADS = 4
MLA_Q_LORA = 256
MLA_KV_LORA = 192
MLA_NOPE = 64
MLA_ROPE = 32
MLA_V = 64
SG_GROUPS = 4
SG_CHUNK = 128
SG_WIDTH = 256
GQA_HEADS = 4
GQA_KV_HEADS = 2
N_BRANCH = 4
BRANCH_WIDTH = 256
FFN_DIM = 2816
CONV_WIDTH = 3

Q_BLOCK = 128
ROPE_THETA = 10000.0
EPS = 1e-6
NEG_INF = -1e30

NA_IN = 3 * NA_HEADS * HEAD_DIM
MLA_IN = MLA_Q_LORA + MLA_KV_LORA + MLA_ROPE
SG_IN = 2 * SG_WIDTH
GQA_IN = (GQA_HEADS + 2 * GQA_KV_HEADS) * HEAD_DIM
IN_WIDTH = NA_IN + MLA_IN + SG_IN + GQA_IN

kernel_name = "hybrid_natten_mla_gmlp_gqa_diffusion_block"


def rms(x):
    xf = x.astype(jnp.float32)
    return (xf * lax.rsqrt(jnp.mean(xf * xf, axis=-1, keepdims=True) + EPS)).astype(x.dtype)


def rope_1d(x, pos):
    half = x.shape[-1] // 2
    inv = ROPE_THETA ** (-jnp.arange(half, dtype=jnp.float32) / half)
    ang = pos.astype(jnp.float32)[:, None] * inv[None, :]
    shape = (ang.shape[0],) + (1,) * (x.ndim - 3) + (half,)
    cos = jnp.cos(ang).reshape(shape).astype(x.dtype)
    sin = jnp.sin(ang).reshape(shape).astype(x.dtype)
    x1, x2 = x[..., :half], x[..., half:]
    return jnp.concatenate([x1 * cos - x2 * sin, x2 * cos + x1 * sin], axis=-1)


def rope_2d(x, rows, cols):
    h = x.shape[-1] // 2
    return jnp.concatenate([rope_1d(x[..., :h], rows), rope_1d(x[..., h:], cols)], axis=-1)


def modulate(x, shift, scale):
    return rms(x) * (1 + scale[:, None]) + shift[:, None]


def softmax_f32(s):
    return jax.nn.softmax(s.astype(jnp.float32), axis=-1)


def prep_na(z, p):
    B, T, _ = z.shape
    qkv = z.reshape(B, T, 3, NA_HEADS, HEAD_DIM)
    q = rms(qkv[:, :, 0]) * p['na_q_norm']
    k = rms(qkv[:, :, 1]) * p['na_k_norm']
    return q, k, qkv[:, :, 2]


def prep_mla(z, p, pos):
    B, T, _ = z.shape
    cq, ckv, k_rope = jnp.split(z, [MLA_Q_LORA, MLA_Q_LORA + MLA_KV_LORA], axis=-1)
    q = ((rms(cq) * p['mla_cq_norm']) @ p['mla_w_uq']).reshape(B, T, MLA_HEADS, MLA_NOPE + MLA_ROPE)
    kv = ((rms(ckv) * p['mla_ckv_norm']) @ p['mla_w_ukv']).reshape(B, T, MLA_HEADS, MLA_NOPE + MLA_V)
    qg, kg = p['mla_q_norm'], p['mla_k_norm']
    q_nope = rms(q[..., :MLA_NOPE]) * qg[:MLA_NOPE]
    q_rope = rms(q[..., MLA_NOPE:]) * qg[MLA_NOPE:]
    k_nope = rms(kv[..., :MLA_NOPE]) * kg[:MLA_NOPE]
    k_rope = rms(k_rope) * kg[MLA_NOPE:]
    v = kv[..., MLA_NOPE:]
    if pos is not None:
        q_rope = rope_2d(q_rope, *pos)
        k_rope = rope_2d(k_rope, *pos)
    q = jnp.concatenate([q_nope, q_rope], axis=-1)[:, :, :, None]
    k = jnp.concatenate([k_nope, jnp.broadcast_to(k_rope[:, :, None], (B, T, MLA_HEADS, MLA_ROPE))], axis=-1)
    return q, k, v


def prep_gqa(z, p, pos):
    B, T, _ = z.shape
    q, k, v = jnp.split(z, [GQA_HEADS * HEAD_DIM, (GQA_HEADS + GQA_KV_HEADS) * HEAD_DIM], axis=-1)
    q = rms(q.reshape(B, T, GQA_KV_HEADS, GQA_HEADS // GQA_KV_HEADS, HEAD_DIM)) * p['gqa_q_norm']
    k = rms(k.reshape(B, T, GQA_KV_HEADS, HEAD_DIM)) * p['gqa_k_norm']
    v = v.reshape(B, T, GQA_KV_HEADS, HEAD_DIM)
    if pos is not None:
        q = rope_2d(q, *pos)
        k = rope_2d(k, *pos)
    return q, k, v


def token_mixing_inputs(h, p, pos):
    z = h @ p['w_in']
    z_na, z_mla, z_sg, z_gqa = jnp.split(z, [NA_IN, NA_IN + MLA_IN, NA_IN + MLA_IN + SG_IN], axis=-1)
    return prep_na(z_na, p), prep_mla(z_mla, p, pos), z_sg, prep_gqa(z_gqa, p, pos)


def attend_ctx(q, k, v, scale):
    s = jnp.einsum('bqgrd,bkgd->bgrqk', q, k) * scale
    p = softmax_f32(s).astype(v.dtype)
    o = jnp.einsum('bgrqk,bkgv->bqgrv', p, v)
    return o.reshape(o.shape[0], o.shape[1], -1)


def attend_latent_blocked(q, k_lat, v_lat, k_ctx, v_ctx, scale):
    B, T, G, R, dq = q.shape
    k_all = jnp.concatenate([k_ctx, k_lat], axis=1)
    v_all = jnp.concatenate([v_ctx, v_lat], axis=1)
    nblk = T // Q_BLOCK
    qb = jnp.moveaxis(q.reshape(B, nblk, Q_BLOCK, G, R, dq), 1, 0)

    def one_block(q_blk):
        s = jnp.einsum('bqgrd,bkgd->bgrqk', q_blk, k_all) * scale
        p = softmax_f32(s).astype(v_all.dtype)
        return jnp.einsum('bgrqk,bkgv->bqgrv', p, v_all)

    o = lax.map(one_block, qb)
    return jnp.moveaxis(o, 0, 1).reshape(B, T, -1)


def neighbourhood_attention(q, k, v, k_ctx, v_ctx, rpb, rows):
    B, T, H, d = q.shape
    kr, kc = min(NA_ROWS, rows), NA_COLS
    scale = d ** -0.5
    qg = q.reshape(B, rows, GRID_W, H, d)
    kg = k.reshape(B, rows, GRID_W, H, d)
    vg = v.reshape(B, rows, GRID_W, H, d)
    r = jnp.arange(rows)
    row_idx = jnp.clip(r - kr // 2, 0, rows - kr)[:, None] + jnp.arange(kr)[None, :]
    col = jnp.arange(GRID_W)
    c_start = jnp.clip(col - kc // 2, 0, GRID_W - kc)
    col_mask = (col[None, :] >= c_start[:, None]) & (col[None, :] < c_start[:, None] + kc)
    k_band = kg[:, row_idx]
    v_band = vg[:, row_idx]
    s_nb = (jnp.einsum('brqhd,brkwhd->bhrqkw', qg, k_band) * scale).astype(jnp.float32)
    dr = row_idx - r[:, None] + (NA_ROWS - 1)
    dc = jnp.clip(col[None, :] - col[:, None] + (NA_COLS - 1), 0, 2 * NA_COLS - 2)
    bias = jnp.take(rpb[:, dr], dc, axis=-1).transpose(0, 1, 3, 2, 4)
    s_nb = jnp.where(col_mask[:, None, :], s_nb + bias.astype(jnp.float32), NEG_INF)
    s_nb = s_nb.reshape(B, H, rows, GRID_W, kr * GRID_W)
    s_cx = (jnp.einsum('brqhd,bkhd->bhrqk', qg, k_ctx) * scale).astype(jnp.float32)
    p = softmax_f32(jnp.concatenate([s_nb, s_cx], axis=-1))
    p_nb = p[..., :kr * GRID_W].reshape(B, H, rows, GRID_W, kr, GRID_W).astype(v.dtype)
    p_cx = p[..., kr * GRID_W:].astype(v.dtype)
    o = (jnp.einsum('bhrqkw,brkwhd->brqhd', p_nb, v_band)
         + jnp.einsum('bhrqk,bkhd->brqhd', p_cx, v_ctx))
    return o.reshape(B, T, H * d)


def spatial_gating(z_sg, p):
    B, T, _ = z_sg.shape
    uv = jax.nn.gelu(z_sg)
    u, v = uv[..., :SG_WIDTH], uv[..., SG_WIDTH:]
    v = rms(v) * p['sg_v_norm']
    vc = v.reshape(B, T // SG_CHUNK, SG_CHUNK, SG_GROUPS, SG_WIDTH // SG_GROUPS)
    mixed = jnp.einsum('gpq,bnqgc->bnpgc', p['sg_w_s'], vc) + p['sg_b_s'].T[None, None, :, :, None]
    return u * mixed.reshape(B, T, SG_WIDTH)


def merge_branches(h, branches, p):
    y = 0
    for i, o in enumerate(branches):
        y = y + jax.nn.sigmoid(h @ p['w_gate'][i] + p['b_gate'][i]) * (o @ p['w_branch'][i])
    return y @ p['w_out']


def dwconv3(x, w, b):
    xp = jnp.pad(x, ((0, 0), (1, 1), (0, 0)))
    return xp[:, :-2] * w[0] + xp[:, 1:-1] * w[1] + xp[:, 2:] * w[2] + b


def conv_ffn(h, p):
    up = dwconv3(h @ p['w_up'], p['conv_w'], p['conv_b'])
    a, g = jnp.split(up, 2, axis=-1)
    return (jax.nn.silu(g) * a) @ p['w_down']


def layer(x, cx, c, c_ctx, p, pos, ctx_out):
    rows = x.shape[1] // GRID_W
    mod = jax.nn.silu(c) @ p['w_ada'] + p['b_ada']
    mod_c = (jax.nn.silu(c_ctx) @ p['w_ada'] + p['b_ada'])[None]
    sh1, sc1, g1, sh2, sc2, g2 = jnp.split(mod, 6, axis=-1)
    csh1, csc1, cg1, csh2, csc2, cg2 = jnp.split(mod_c, 6, axis=-1)

    h = modulate(x, sh1, sc1)
    hc = modulate(cx, csh1, csc1)
    na, mla, sg, gqa = token_mixing_inputs(h, p, pos)
    na_c, mla_c, sg_c, gqa_c = token_mixing_inputs(hc, p, None)

    o_na = neighbourhood_attention(na[0], na[1], na[2], na_c[1], na_c[2], p['na_rpb'], rows)
    o_mla = attend_latent_blocked(mla[0], mla[1], mla[2], mla_c[1], mla_c[2], (MLA_NOPE + MLA_ROPE) ** -0.5)
    o_sg = spatial_gating(sg, p)
    o_gqa = attend_latent_blocked(gqa[0], gqa[1], gqa[2], gqa_c[1], gqa_c[2], HEAD_DIM ** -0.5)
    x = x + g1[:, None] * merge_branches(h, (o_na, o_mla, o_sg, o_gqa), p)
    x = x + g2[:, None] * conv_ffn(modulate(x, sh2, sc2), p)

    if ctx_out:
        oc_na = attend_ctx(na_c[0][:, :, :, None], na_c[1], na_c[2], HEAD_DIM ** -0.5)
        oc_mla = attend_ctx(mla_c[0], mla_c[1], mla_c[2], (MLA_NOPE + MLA_ROPE) ** -0.5)
        oc_sg = spatial_gating(sg_c, p)
        oc_gqa = attend_ctx(gqa_c[0], gqa_c[1], gqa_c[2], HEAD_DIM ** -0.5)
        cx = cx + cg1[:, None] * merge_branches(hc, (oc_na, oc_mla, oc_sg, oc_gqa), p)
        cx = cx + cg2[:, None] * conv_ffn(modulate(cx, csh2, csc2), p)
    return x, cx


def setup_inputs(seed: int = 0) -> dict:
    key = jax.random.key(seed)
    ks = jax.random.split(key, 32)
    L, D = DEPTH, D_MODEL

    def nrm(k, shape, fan_in):
        return jax.random.normal(k, shape, jnp.float32) * fan_in ** -0.5

    def gain(k, shape):
        return 1.0 + 0.02 * jax.random.normal(k, shape, jnp.float32)

    def small(k, shape):
        return 0.02 * jax.random.normal(k, shape, jnp.float32)

    return {
        'x': jax.random.normal(ks[0], (BATCH, SEQ, D), jnp.float32),
        'c': jax.random.normal(ks[1], (BATCH, D), jnp.float32),
        'ctx': jax.random.normal(ks[2], (BATCH, CTX_LEN, D), jnp.float32),
        'c_ctx': jax.random.normal(ks[3], (D,), jnp.float32),
        'w_ada': nrm(ks[4], (L, D, 6 * D), D),
        'b_ada': small(ks[5], (L, 6 * D)),
        'w_in': nrm(ks[6], (L, D, IN_WIDTH), D),
        'na_q_norm': gain(ks[7], (L, HEAD_DIM)),
        'na_k_norm': gain(ks[8], (L, HEAD_DIM)),
        'na_rpb': small(ks[9], (L, NA_HEADS, 2 * NA_ROWS - 1, 2 * NA_COLS - 1)),
        'mla_cq_norm': gain(ks[10], (L, MLA_Q_LORA)),
        'mla_ckv_norm': gain(ks[11], (L, MLA_KV_LORA)),
        'mla_w_uq': nrm(ks[12], (L, MLA_Q_LORA, MLA_HEADS * (MLA_NOPE + MLA_ROPE)), MLA_Q_LORA),
        'mla_w_ukv': nrm(ks[13], (L, MLA_KV_LORA, MLA_HEADS * (MLA_NOPE + MLA_V)), MLA_KV_LORA),
        'mla_q_norm': gain(ks[14], (L, MLA_NOPE + MLA_ROPE)),
        'mla_k_norm': gain(ks[15], (L, MLA_NOPE + MLA_ROPE)),
        'sg_v_norm': gain(ks[16], (L, SG_WIDTH)),
        'sg_w_s': nrm(ks[17], (L, SG_GROUPS, SG_CHUNK, SG_CHUNK), SG_CHUNK),
        'sg_b_s': gain(ks[18], (L, SG_GROUPS, SG_CHUNK)),
        'gqa_q_norm': gain(ks[19], (L, HEAD_DIM)),
        'gqa_k_norm': gain(ks[20], (L, HEAD_DIM)),
        'w_branch': nrm(ks[21], (L, N_BRANCH, BRANCH_WIDTH, D), BRANCH_WIDTH),
        'w_gate': nrm(ks[22], (L, N_BRANCH, D, D), D),
        'b_gate': small(ks[23], (L, N_BRANCH, D)),
        'w_out': nrm(ks[24], (L, D, D), D),
        'w_up': nrm(ks[25], (L, D, 2 * FFN_DIM), D),
        'conv_w': nrm(ks[26], (L, CONV_WIDTH, 2 * FFN_DIM), CONV_WIDTH),
        'conv_b': small(ks[27], (L, 2 * FFN_DIM)),
        'w_down': nrm(ks[28], (L, FFN_DIM, D), FFN_DIM),
    }


def reference(x, c, ctx, c_ctx, w_ada, b_ada, w_in, na_q_norm, na_k_norm, na_rpb,
              mla_cq_norm, mla_ckv_norm, mla_w_uq, mla_w_ukv, mla_q_norm, mla_k_norm,
              sg_v_norm, sg_w_s, sg_b_s, gqa_q_norm, gqa_k_norm,
              w_branch, w_gate, b_gate, w_out, w_up, conv_w, conv_b, w_down):
    T = x.shape[1]
    t = jnp.arange(T)
    pos = (t // GRID_W, t % GRID_W)
    cx = ctx
    for l in range(DEPTH):
        p = {
            'w_ada': w_ada[l], 'b_ada': b_ada[l], 'w_in': w_in[l],
            'na_q_norm': na_q_norm[l], 'na_k_norm': na_k_norm[l], 'na_rpb': na_rpb[l],
            'mla_cq_norm': mla_cq_norm[l], 'mla_ckv_norm': mla_ckv_norm[l],
            'mla_w_uq': mla_w_uq[l], 'mla_w_ukv': mla_w_ukv[l],
            'mla_q_norm': mla_q_norm[l], 'mla_k_norm': mla_k_norm[l],
            'sg_v_norm': sg_v_norm[l], 'sg_w_s': sg_w_s[l], 'sg_b_s': sg_b_s[l],
            'gqa_q_norm': gqa_q_norm[l], 'gqa_k_norm': gqa_k_norm[l],
            'w_branch': w_branch[l], 'w_gate': w_gate[l], 'b_gate': b_gate[l], 'w_out': w_out[l],
            'w_up': w_up[l], 'conv_w': conv_w[l], 'conv_b': conv_b[l], 'w_down': w_down[l],
        }
        x, cx = layer(x, cx, c, c_ctx, p, pos, l < DEPTH - 1)
    return x
```

```cpp
#include <hip/hip_runtime.h>
#include <hip/hip_bf16.h>
#include <hip/hip_cooperative_groups.h>
#include <cstdio>
#include <cstdint>
namespace cg = cooperative_groups;

typedef unsigned short u16;
using bf16x8 = __attribute__((ext_vector_type(8))) short;
using f32x4 = __attribute__((ext_vector_type(4))) float;
using u32x4 = __attribute__((ext_vector_type(4))) unsigned;

#define DEV __device__ __forceinline__
#ifndef REP_P0
#define REP_P0 1
#endif
#ifndef REP_SYNC
#define REP_SYNC 0
#endif
#ifndef REP_P3
#define REP_P3 1
#endif
#ifndef REP_P8
#define REP_P8 1
#endif
#ifndef REP_P11
#define REP_P11 1
#endif
#ifndef REP_P1
#define REP_P1 1
#endif
#ifndef REP_P2
#define REP_P2 1
#endif
#ifndef REP_P4
#define REP_P4 1
#endif
#ifndef REP_P6
#define REP_P6 1
#endif
#ifndef REP_P7
#define REP_P7 1
#endif
#ifndef REP_P9
#define REP_P9 1
#endif
#ifndef REP_P10
#define REP_P10 1
#endif

constexpr int NB = 4, TT = 8192, CC = 256, SS = 8448, MM = NB * SS, DD = 1024;
constexpr int ZW = 2304, FF = 2816;
constexpr float EPS = 1e-6f;
constexpr float LOG2E = 1.4426950408889634f;

constexpr size_t OW_IN = 0;
constexpr size_t OW_GATE = OW_IN + (size_t)2304 * 1024;
constexpr size_t OW_BRANCH = OW_GATE + (size_t)4 * 1024 * 1024;
constexpr size_t OW_OUT = OW_BRANCH + (size_t)4 * 1024 * 256;
constexpr size_t OW_UP = OW_OUT + (size_t)1024 * 1024;
constexpr size_t OW_DOWN = OW_UP + (size_t)5632 * 1024;
constexpr size_t OW_UQ = OW_DOWN + (size_t)1024 * 2816;
constexpr size_t OW_UKV = OW_UQ + (size_t)384 * 256;
constexpr size_t OW_SG = OW_UKV + (size_t)512 * 192;
constexpr size_t WL = OW_SG + (size_t)4 * 128 * 128;

constexpr size_t WS_W = 0;
constexpr size_t WS_MOD = WS_W + 2 * WL * 2;
constexpr size_t WS_R16 = WS_MOD + (size_t)2 * 5 * 6144 * 4;
constexpr size_t WS_R8 = WS_R16 + (size_t)128 * 16 * 8;
constexpr size_t WS_CX = WS_R8 + (size_t)128 * 8 * 8;
constexpr size_t WS_H = WS_CX + (size_t)NB * CC * DD * 4;
constexpr size_t WS_Z = WS_H + (size_t)MM * DD * 2;
constexpr size_t WS_QKV = WS_Z + (size_t)MM * ZW * 2;
constexpr size_t WS_ZROW = WS_QKV + (size_t)MM * FF * 2;
constexpr size_t WS_BAR = WS_ZROW + 4096;
constexpr size_t WS_MREF = WS_BAR + 3456 * 4;
constexpr size_t WS_END = WS_MREF + 64;

constexpr size_t Q_NA = 0;
constexpr size_t K_NA = (size_t)MM * 256;
constexpr size_t V_NA = (size_t)MM * 512;
constexpr size_t Q_MLA = (size_t)MM * 768;
constexpr size_t K_MLA = (size_t)MM * 1152;
constexpr size_t V_MLA = (size_t)MM * 1536;
constexpr size_t Q_GQA = (size_t)MM * 1792;
constexpr size_t K_GQA = (size_t)MM * 2048;
constexpr size_t V_GQA = (size_t)MM * 2176;
constexpr size_t SG_U = (size_t)MM * 2304;
constexpr size_t SG_VT = (size_t)MM * 2560;

constexpr int SMEM_BYTES = 67584;

struct Params {
  const float* in[29];
  float* out;
  char* ws;
  long pad;
};

DEV float bf2f(u16 h) { return __uint_as_float(((unsigned)h) << 16); }
DEV u16 f2bf(float f) {
  __bf16 r = (__bf16)f;
  return __builtin_bit_cast(u16, r);
}
typedef __bf16 bf16x2_t __attribute__((ext_vector_type(2)));
typedef float f32x2_t __attribute__((ext_vector_type(2)));
DEV unsigned pack2(float a, float b) {
  f32x2_t v = {a, b};
  bf16x2_t r = __builtin_convertvector(v, bf16x2_t);
  return __builtin_bit_cast(unsigned, r);
}
DEV void load8(const u16* p, float (&f)[8]) {
  uint4 v = *(const uint4*)p;
  f[0] = __uint_as_float(v.x << 16); f[1] = __uint_as_float(v.x & 0xffff0000u);
  f[2] = __uint_as_float(v.y << 16); f[3] = __uint_as_float(v.y & 0xffff0000u);
  f[4] = __uint_as_float(v.z << 16); f[5] = __uint_as_float(v.z & 0xffff0000u);
  f[6] = __uint_as_float(v.w << 16); f[7] = __uint_as_float(v.w & 0xffff0000u);
}
DEV void store8(u16* p, const float (&f)[8]) {
  uint4 v;
  v.x = pack2(f[0], f[1]); v.y = pack2(f[2], f[3]); v.z = pack2(f[4], f[5]); v.w = pack2(f[6], f[7]);
  *(uint4*)p = v;
}
DEV float silu_f(float x) { return x * __builtin_amdgcn_rcpf(1.f + __expf(-x)); }
DEV float sigmoid_f(float x) { return __builtin_amdgcn_rcpf(1.f + __expf(-x)); }
DEV float gelu_f(float x) {
  float y = 0.7978845608028654f * (x + 0.044715f * x * x * x);
  float t = 1.f - 2.f * __builtin_amdgcn_rcpf(__expf(2.f * y) + 1.f);
  return 0.5f * x * (1.f + t);
}
DEV int perm32(int s) {
  int k = s & 31;
  int pos = ((k >> 2) & 3) * 8 + (k >> 4) * 4 + (k & 3);
  return (s & ~31) | pos;
}
DEV int opaque_tid() { int t = threadIdx.x; asm volatile("" : "+v"(t)); return t; }
DEV float shfl_xor_f(float v, int mask) {
  int ln = __builtin_amdgcn_mbcnt_hi(~0u, __builtin_amdgcn_mbcnt_lo(~0u, 0u));
  asm volatile("" : "+v"(ln));
  return __int_as_float(__builtin_amdgcn_ds_bpermute((ln ^ mask) << 2, __float_as_int(v)));
}
DEV int clampi(int v, int lo, int hi) { return v < lo ? lo : (v > hi ? hi : v); }

struct XMap { float* lat; float* ctx; };
DEV float* xrow(const XMap& xm, int m) {
  int b = m / SS;
  int s = m - b * SS;
  return s < CC ? xm.ctx + ((size_t)(b * CC + s)) * DD : xm.lat + ((size_t)(b * TT + s - CC)) * DD;
}

template <int BN, class AF, class BF>
DEV void gemm_core(AF arow, BF brow, int nk, f32x4 (&acc)[4][BN / 32], u16* lds) {
  constexpr int NF = BN / 32;
  constexpr int STAGE = (128 + BN) * 64;
  constexpr int NBI = (BN * 8) / 256;
  static_assert((BN * 8) % 256 == 0, "BN");
  const int tid = opaque_tid(), lane = tid & 63, w = tid >> 6, l15 = lane & 15, quad = lane >> 4;
  const int wm = w >> 1, wn = w & 1;
  const u16* ap[4];
  const u16* bp[NBI];
#pragma unroll
  for (int i = 0; i < 4; i++) {
    int c = tid + i * 256;
    ap[i] = arow(c >> 3) + (c & 7) * 8;
  }
#pragma unroll
  for (int i = 0; i < NBI; i++) {
    int c = tid + i * 256;
    bp[i] = brow(c >> 3) + (c & 7) * 8;
  }
  const int srow = tid >> 3;
  const int soff = srow * 64 + (((tid & 7) ^ ((srow >> 1) & 7)) * 8);
  const int swz = (l15 >> 1) & 7;
  u32x4 r0a[4], r0b[NBI], r1a[4], r1b[NBI];
#pragma unroll
  for (int i = 0; i < 4; i++)
#pragma unroll
    for (int j = 0; j < NF; j++) acc[i][j] = f32x4{0.f, 0.f, 0.f, 0.f};

#define GLOAD(RA, RB, KT)                                                              \
  {                                                                                    \
    _Pragma("unroll") for (int i = 0; i < 4; i++) RA[i] = *(const u32x4*)(ap[i] + (KT) * 64);   \
    _Pragma("unroll") for (int i = 0; i < NBI; i++) RB[i] = *(const u32x4*)(bp[i] + (KT) * 64); \
  }
#define SSTORE(RA, RB, ST)                                                             \
  {                                                                                    \
    u16* A_ = lds + (ST) * STAGE;                                                      \
    u16* B_ = A_ + 128 * 64;                                                           \
    _Pragma("unroll") for (int i = 0; i < 4; i++) *(u32x4*)(A_ + soff + i * 32 * 64) = RA[i];   \
    _Pragma("unroll") for (int i = 0; i < NBI; i++) *(u32x4*)(B_ + soff + i * 32 * 64) = RB[i]; \
  }
#define LFRAGS(ST)                                                                     \
    const u16* A_ = lds + (ST) * STAGE;                                                \
    const u16* B_ = A_ + 128 * 64;                                                     \
    bf16x8 af[2][4], bfr[2][NF];                                                       \
    _Pragma("unroll") for (int ks = 0; ks < 2; ks++) {                                 \
      const int co = (((ks * 4 + quad) ^ swz) * 8);                                    \
      _Pragma("unroll") for (int i = 0; i < 4; i++) af[ks][i] = *(const bf16x8*)(A_ + (wm * 64 + i * 16 + l15) * 64 + co);          \
      _Pragma("unroll") for (int j = 0; j < NF; j++) bfr[ks][j] = *(const bf16x8*)(B_ + (wn * (BN / 2) + j * 16 + l15) * 64 + co);  \
    }
#define MFMAS(KS)                                                                      \
    _Pragma("unroll") for (int i = 0; i < 4; i++)                                      \
      _Pragma("unroll") for (int j = 0; j < NF; j++)                                   \
        acc[i][j] = __builtin_amdgcn_mfma_f32_16x16x32_bf16(af[KS][i], bfr[KS][j], acc[i][j], 0, 0, 0);

  __syncthreads();
  GLOAD(r0a, r0b, 0);
  if (nk > 1) GLOAD(r1a, r1b, 1);
  SSTORE(r0a, r0b, 0);
  __syncthreads();
  for (int kt = 0; kt < nk; kt += 2) {
    {
      if (kt + 2 < nk) GLOAD(r0a, r0b, kt + 2);
      LFRAGS(0);
      __builtin_amdgcn_sched_barrier(0);
      MFMAS(0);
      __builtin_amdgcn_sched_barrier(0);
      if (kt + 1 < nk) SSTORE(r1a, r1b, 1);
      __builtin_amdgcn_sched_barrier(0);
      MFMAS(1);
      __syncthreads();
    }
    if (kt + 1 >= nk) break;
    {
      if (kt + 3 < nk) GLOAD(r1a, r1b, kt + 3);
      LFRAGS(1);
      __builtin_amdgcn_sched_barrier(0);
      MFMAS(0);
      __builtin_amdgcn_sched_barrier(0);
      if (kt + 2 < nk) SSTORE(r0a, r0b, 0);
      __builtin_amdgcn_sched_barrier(0);
      MFMAS(1);
      __syncthreads();
    }
  }
#undef GLOAD
#undef SSTORE
#undef LFRAGS
#undef MFMAS
}

template <int BN, class AF1, class BF1, class AF2, class BF2>
DEV void gemm_dual(AF1 arow1, BF1 brow1, int nk1, f32x4 (&acc1)[4][BN / 32], AF2 arow2, BF2 brow2, int nk2,
                   f32x4 (&acc2)[4][BN / 32], u16* lds) {
  constexpr int NF = BN / 32;
  constexpr int STAGE = (128 + BN) * 64;
  constexpr int NBI = (BN * 8) / 256;
  const int tid = opaque_tid(), lane = tid & 63, w = tid >> 6, l15 = lane & 15, quad = lane >> 4;
  const int wm = w >> 1, wn = w & 1;
  const int nk = nk1 + nk2;
  const u16* ap1[4]; const u16* bp1[NBI]; const u16* ap2[4]; const u16* bp2[NBI];
#pragma unroll
  for (int i = 0; i < 4; i++) {
    int c = tid + i * 256;
    ap1[i] = arow1(c >> 3) + (c & 7) * 8;
    ap2[i] = arow2(c >> 3) + (c & 7) * 8 - (size_t)nk1 * 64;
  }
#pragma unroll
  for (int i = 0; i < NBI; i++) {
    int c = tid + i * 256;
    bp1[i] = brow1(c >> 3) + (c & 7) * 8;
    bp2[i] = brow2(c >> 3) + (c & 7) * 8 - (size_t)nk1 * 64;
  }
  const int srow = tid >> 3;
  const int soff = srow * 64 + (((tid & 7) ^ ((srow >> 1) & 7)) * 8);
  const int swz = (l15 >> 1) & 7;
  u32x4 r0a[4], r0b[NBI], r1a[4], r1b[NBI];
#pragma unroll
  for (int i = 0; i < 4; i++)
#pragma unroll
    for (int j = 0; j < NF; j++) { acc1[i][j] = f32x4{0.f, 0.f, 0.f, 0.f}; acc2[i][j] = f32x4{0.f, 0.f, 0.f, 0.f}; }

#define GLOAD(RA, RB, KT)                                                              \
  {                                                                                    \
    const bool s2_ = (KT) >= nk1;                                                      \
    _Pragma("unroll") for (int i = 0; i < 4; i++) RA[i] = *(const u32x4*)((s2_ ? ap2[i] : ap1[i]) + (KT) * 64);   \
    _Pragma("unroll") for (int i = 0; i < NBI; i++) RB[i] = *(const u32x4*)((s2_ ? bp2[i] : bp1[i]) + (KT) * 64); \
  }
#define SSTORE(RA, RB, ST)                                                             \
  {                                                                                    \
    u16* A_ = lds + (ST) * STAGE;                                                      \
    u16* B_ = A_ + 128 * 64;                                                           \
    _Pragma("unroll") for (int i = 0; i < 4; i++) *(u32x4*)(A_ + soff + i * 32 * 64) = RA[i];   \
    _Pragma("unroll") for (int i = 0; i < NBI; i++) *(u32x4*)(B_ + soff + i * 32 * 64) = RB[i]; \
  }
#define LFRAGS(ST)                                                                     \
    const u16* A_ = lds + (ST) * STAGE;                                                \
    const u16* B_ = A_ + 128 * 64;                                                     \
    bf16x8 af[2][4], bfr[2][NF];                                                       \
    _Pragma("unroll") for (int ks = 0; ks < 2; ks++) {                                 \
      const int co = (((ks * 4 + quad) ^ swz) * 8);                                    \
      _Pragma("unroll") for (int i = 0; i < 4; i++) af[ks][i] = *(const bf16x8*)(A_ + (wm * 64 + i * 16 + l15) * 64 + co);          \
      _Pragma("unroll") for (int j = 0; j < NF; j++) bfr[ks][j] = *(const bf16x8*)(B_ + (wn * (BN / 2) + j * 16 + l15) * 64 + co);  \
    }
#define MFMAS(ACC, KS)                                                                 \
    _Pragma("unroll") for (int i = 0; i < 4; i++)                                      \
      _Pragma("unroll") for (int j = 0; j < NF; j++)                                   \
        ACC[i][j] = __builtin_amdgcn_mfma_f32_16x16x32_bf16(af[KS][i], bfr[KS][j], ACC[i][j], 0, 0, 0);
#define STEP_PAIR(ACC)                                                                 \
    {                                                                                  \
      if (kt + 2 < nk) GLOAD(r0a, r0b, kt + 2);                                        \
      LFRAGS(0);                                                                       \
      __builtin_amdgcn_sched_barrier(0);                                               \
      MFMAS(ACC, 0);                                                                   \
      __builtin_amdgcn_sched_barrier(0);                                               \
      SSTORE(r1a, r1b, 1);                                                             \
      __builtin_amdgcn_sched_barrier(0);                                               \
      MFMAS(ACC, 1);                                                                   \
      __syncthreads();                                                                 \
    }                                                                                  \
    {                                                                                  \
      if (kt + 3 < nk) GLOAD(r1a, r1b, kt + 3);                                        \
      LFRAGS(1);                                                                       \
      __builtin_amdgcn_sched_barrier(0);                                               \
      MFMAS(ACC, 0);                                                                   \
      __builtin_amdgcn_sched_barrier(0);                                               \
      if (kt + 2 < nk) SSTORE(r0a, r0b, 0);                                            \
      __builtin_amdgcn_sched_barrier(0);                                               \
      MFMAS(ACC, 1);                                                                   \
      __syncthreads();                                                                 \
    }

  __syncthreads();
  GLOAD(r0a, r0b, 0);
  GLOAD(r1a, r1b, 1);
  SSTORE(r0a, r0b, 0);
  __syncthreads();
  for (int kt = 0; kt < nk1; kt += 2) { STEP_PAIR(acc1) }
  for (int kt = nk1; kt < nk; kt += 2) { STEP_PAIR(acc2) }
#undef GLOAD
#undef SSTORE
#undef LFRAGS
#undef MFMAS
#undef STEP_PAIR
}

template <class AF, class BF>
DEV void gemm_wide(AF arow, BF brow, int nk, f32x4 (&acc)[4][8], u16* lds) {
  constexpr int STAGE = (128 + 256) * 32;
  const int tid = opaque_tid(), lane = tid & 63, w = tid >> 6, l15 = lane & 15, quad = lane >> 4;
  const int wm = w >> 1, wn = w & 1;
  const u16* ap[2];
  const u16* bp[4];
#pragma unroll
  for (int i = 0; i < 2; i++) {
    int c = tid + i * 256;
    ap[i] = arow(c >> 2) + (c & 3) * 8;
  }
#pragma unroll
  for (int i = 0; i < 4; i++) {
    int c = tid + i * 256;
    bp[i] = brow(c >> 2) + (c & 3) * 8;
  }
  u32x4 ra[2], rb[4];
#pragma unroll
  for (int i = 0; i < 4; i++)
#pragma unroll
    for (int j = 0; j < 8; j++) acc[i][j] = f32x4{0.f, 0.f, 0.f, 0.f};
  __syncthreads();
#pragma unroll
  for (int i = 0; i < 2; i++) ra[i] = *(const u32x4*)(ap[i]);
#pragma unroll
  for (int i = 0; i < 4; i++) rb[i] = *(const u32x4*)(bp[i]);
  {
    u16* A_ = lds;
    u16* B_ = A_ + 128 * 32;
#pragma unroll
    for (int i = 0; i < 2; i++) *(u32x4*)(A_ + (tid + i * 256) * 8) = ra[i];
#pragma unroll
    for (int i = 0; i < 4; i++) *(u32x4*)(B_ + (tid + i * 256) * 8) = rb[i];
  }
  __syncthreads();
  for (int kt = 0; kt < nk; kt++) {
    const bool more = (kt + 1 < nk);
    if (more) {
#pragma unroll
      for (int i = 0; i < 2; i++) ra[i] = *(const u32x4*)(ap[i] + (kt + 1) * 32);
#pragma unroll
      for (int i = 0; i < 4; i++) rb[i] = *(const u32x4*)(bp[i] + (kt + 1) * 32);
    }
    const u16* A_ = lds + (kt & 1) * STAGE;
    const u16* B_ = A_ + 128 * 32;
    bf16x8 af[4], bfr[8];
#pragma unroll
    for (int i = 0; i < 4; i++) af[i] = *(const bf16x8*)(A_ + (wm * 64 + i * 16 + l15) * 32 + quad * 8);
#pragma unroll
    for (int j = 0; j < 8; j++) bfr[j] = *(const bf16x8*)(B_ + (wn * 128 + j * 16 + l15) * 32 + quad * 8);
    __builtin_amdgcn_sched_barrier(0);
#pragma unroll
    for (int j = 0; j < 4; j++)
#pragma unroll
      for (int i = 0; i < 4; i++) acc[i][j] = __builtin_amdgcn_mfma_f32_16x16x32_bf16(af[i], bfr[j], acc[i][j], 0, 0, 0);
    __builtin_amdgcn_sched_barrier(0);
    if (more) {
      u16* A2 = lds + ((kt + 1) & 1) * STAGE;
      u16* B2 = A2 + 128 * 32;
#pragma unroll
      for (int i = 0; i < 2; i++) *(u32x4*)(A2 + (tid + i * 256) * 8) = ra[i];
#pragma unroll
      for (int i = 0; i < 4; i++) *(u32x4*)(B2 + (tid + i * 256) * 8) = rb[i];
    }
    __builtin_amdgcn_sched_barrier(0);
#pragma unroll
    for (int j = 4; j < 8; j++)
#pragma unroll
      for (int i = 0; i < 4; i++) acc[i][j] = __builtin_amdgcn_mfma_f32_16x16x32_bf16(af[i], bfr[j], acc[i][j], 0, 0, 0);
    __syncthreads();
  }
}
#define ACC_COLW(j) (wn * 128 + (j) * 16 + l15)

#define ACC_ROW(i, e) (wm * 64 + (i) * 16 + quad * 4 + (e))
#define ACC_COL(BN, j) (wn * ((BN) / 2) + (j) * 16 + l15)

template <int BN>
DEV void acc_to_lds(f32x4 (&acc)[4][BN / 32], float* st) {
  const int tid = opaque_tid(), lane = tid & 63, w = tid >> 6, l15 = lane & 15, quad = lane >> 4;
  const int wm = w >> 1, wn = w & 1;
#pragma unroll
  for (int i = 0; i < 4; i++)
#pragma unroll
    for (int j = 0; j < BN / 32; j++)
#pragma unroll
      for (int e = 0; e < 4; e++) st[ACC_ROW(i, e) * (BN + 1) + ACC_COL(BN, j)] = acc[i][j][e];
}

template <int DQ, bool NA>
DEV void attn_item(const u16* __restrict__ Qb, const u16* __restrict__ Kb, const u16* __restrict__ Vt, int q0, int t0,
                   int n0, int t1, int n1, float sc2, float mref2, u16* __restrict__ Op, int r0, const float* __restrict__ rpbh,
                   u16* lds, float* rpb_lds) {
  constexpr int NDC = DQ / 32;
  constexpr int KT = 64 * DQ, VT = 64 * 64, STAGE = KT + VT;
#define KOFF(row, kc) (((kc) < 8) ? ((row) * 64 + ((((kc) ^ (((row) >> 1) & 7))) * 8)) : (4096 + (row) * 32 + ((kc) - 8) * 8))
#define VOFF(dv, kc) ((dv) * 64 + ((((kc) ^ (((dv) >> 1) & 7))) * 8))
  constexpr int CPR = DQ / 8;
  constexpr int NKI = (64 * CPR) / 256;
  const int tid = opaque_tid(), lane = tid & 63, w = tid >> 6, l15 = lane & 15, quad = lane >> 4;
  __syncthreads();
  if (NA) {
    for (int i = tid; i < 465; i += 256) rpb_lds[i] = rpbh[i] * (LOG2E / sc2);
  }
  bf16x8 qf[2][NDC];
#pragma unroll
  for (int qg = 0; qg < 2; qg++)
#pragma unroll
    for (int dc = 0; dc < NDC; dc++)
      qf[qg][dc] = *(const bf16x8*)(Qb + (size_t)(q0 + w * 32 + qg * 16 + l15) * DQ + dc * 32 + quad * 8);
  u32x4 rk[NKI], rv[2];
  const int nt = n0 + n1;
  f32x4 o[4][2];
#pragma unroll
  for (int dg = 0; dg < 4; dg++)
#pragma unroll
    for (int qg = 0; qg < 2; qg++) o[dg][qg] = f32x4{0.f, 0.f, 0.f, 0.f};
  float lrun[2] = {0.f, 0.f};
  f32x4 zero4 = f32x4{0.f, 0.f, 0.f, 0.f};
  asm volatile("" : "+v"(zero4));

  {
    const int t = (0 < n0) ? t0 : t1;
#pragma unroll
    for (int i = 0; i < NKI; i++) {
      int c = tid + i * 256;
      int row = c / CPR, kc = c % CPR;
      rk[i] = *(const u32x4*)(Kb + (size_t)t * (64 * DQ) + (unsigned)(row * DQ + kc * 8));
    }
#pragma unroll
    for (int i = 0; i < 2; i++) {
      int c = tid + i * 256;
      int dv = c >> 3, kc = c & 7;
      rv[i] = *(const u32x4*)(Vt + (size_t)t * 64 + (unsigned)(dv * SS + kc * 8));
    }
    u16* Ks = lds;
    u16* Vs = Ks + KT;
#pragma unroll
    for (int i = 0; i < NKI; i++) {
      int c = tid + i * 256;
      int row = c / CPR, kc = c % CPR;
      *(u32x4*)(Ks + KOFF(row, kc)) = rk[i];
    }
#pragma unroll
    for (int i = 0; i < 2; i++) {
      int c = tid + i * 256;
      int dv = c >> 3, kc = c & 7;
      *(u32x4*)(Vs + VOFF(dv, kc)) = rv[i];
    }
  }
  __syncthreads();
  for (int it = 0; it < nt; it++) {
    const bool more = (it + 1 < nt);
    if (more) {
      const int t = (it + 1 < n0) ? (t0 + it + 1) : (t1 + it + 1 - n0);
#pragma unroll
      for (int i = 0; i < NKI; i++) {
        int c = tid + i * 256;
        int row = c / CPR, kc = c % CPR;
        rk[i] = *(const u32x4*)(Kb + (size_t)t * (64 * DQ) + (unsigned)(row * DQ + kc * 8));
      }
#pragma unroll
      for (int i = 0; i < 2; i++) {
        int c = tid + i * 256;
        int dv = c >> 3, kc = c & 7;
        rv[i] = *(const u32x4*)(Vt + (size_t)t * 64 + (unsigned)(dv * SS + kc * 8));
      }
    }
    const u16* Ks = lds + (it & 1) * STAGE;
    const u16* Vs = Ks + KT;
    f32x4 s[4][2];
    {
      bf16x8 kf[NDC][4];
#pragma unroll
      for (int dc = 0; dc < NDC; dc++)
#pragma unroll
        for (int kg = 0; kg < 4; kg++) kf[dc][kg] = *(const bf16x8*)(Ks + KOFF(kg * 16 + l15, dc * 4 + quad));
#pragma unroll
      for (int kg = 0; kg < 4; kg++)
#pragma unroll
        for (int qg = 0; qg < 2; qg++) s[kg][qg] = __builtin_amdgcn_mfma_f32_16x16x32_bf16(kf[0][kg], qf[qg][0], zero4, 0, 0, 0);
#pragma unroll
      for (int dc = 1; dc < NDC; dc++)
#pragma unroll
        for (int kg = 0; kg < 4; kg++)
#pragma unroll
          for (int qg = 0; qg < 2; qg++) s[kg][qg] = __builtin_amdgcn_mfma_f32_16x16x32_bf16(kf[dc][kg], qf[qg][dc], s[kg][qg], 0, 0, 0);
    }
    bf16x8 vf[2][4];
#pragma unroll
    for (int t2 = 0; t2 < 2; t2++)
#pragma unroll
      for (int dg = 0; dg < 4; dg++) vf[t2][dg] = *(const bf16x8*)(Vs + VOFF(dg * 16 + l15, t2 * 4 + quad));
    if (NA) {
      const bool band = (it >= n0);
      if (band) {
        const int kr = t1 + (it - n0) - 4;
        const int r = r0 + (w >> 1);
        const int rs = clampi(r - 4, 0, 120);
        const bool rowok = (kr >= rs) && (kr < rs + 8);
#pragma unroll
        for (int qg = 0; qg < 2; qg++) {
          const int qc = (w & 1) * 32 + qg * 16 + l15;
          const int cs = clampi(qc - 8, 0, 48);
#pragma unroll
          for (int kg = 0; kg < 4; kg++)
#pragma unroll
            for (int e = 0; e < 4; e++) {
              const int kc = kg * 16 + quad * 4 + e;
              const bool ok = rowok && (kc >= cs) && (kc < cs + 16);
              int bi = (kr - r + 7) * 31 + (kc - qc + 15);
              bi = ok ? bi : 0;
              s[kg][qg][e] = ok ? (s[kg][qg][e] + rpb_lds[bi]) : -1e30f;
            }
        }
      }
    }
#pragma unroll
    for (int qg = 0; qg < 2; qg++) {
      float ps = 0.f;
#pragma unroll
      for (int kg = 0; kg < 4; kg++)
#pragma unroll
        for (int e = 0; e < 4; e++) {
          float pv = __builtin_amdgcn_exp2f(fmaf(s[kg][qg][e], sc2, -mref2));
          s[kg][qg][e] = pv;
          ps += pv;
        }
      lrun[qg] += ps;
    }
#pragma unroll
    for (int t2 = 0; t2 < 2; t2++) {
      bf16x8 pb[2];
#pragma unroll
      for (int qg = 0; qg < 2; qg++) {
        u32x4 cv;
        cv[0] = pack2(s[2 * t2][qg][0], s[2 * t2][qg][1]);
        cv[1] = pack2(s[2 * t2][qg][2], s[2 * t2][qg][3]);
        cv[2] = pack2(s[2 * t2 + 1][qg][0], s[2 * t2 + 1][qg][1]);
        cv[3] = pack2(s[2 * t2 + 1][qg][2], s[2 * t2 + 1][qg][3]);
        pb[qg] = __builtin_bit_cast(bf16x8, cv);
      }
#pragma unroll
      for (int dg = 0; dg < 4; dg++) {
#pragma unroll
        for (int qg = 0; qg < 2; qg++) o[dg][qg] = __builtin_amdgcn_mfma_f32_16x16x32_bf16(vf[t2][dg], pb[qg], o[dg][qg], 0, 0, 0);
      }
    }
    if (more) {
      u16* K2 = lds + ((it + 1) & 1) * STAGE;
      u16* V2 = K2 + KT;
#pragma unroll
      for (int i = 0; i < NKI; i++) {
        int c = tid + i * 256;
        int row = c / CPR, kc = c % CPR;
        *(u32x4*)(K2 + KOFF(row, kc)) = rk[i];
      }
#pragma unroll
      for (int i = 0; i < 2; i++) {
        int c = tid + i * 256;
        int dv = c >> 3, kc = c & 7;
        *(u32x4*)(V2 + VOFF(dv, kc)) = rv[i];
      }
    }
    __syncthreads();
  }
#pragma unroll
  for (int qg = 0; qg < 2; qg++) {
    float l = lrun[qg];
    l += shfl_xor_f(l, 16);
    l += shfl_xor_f(l, 32);
    const float inv = 1.f / l;
    u16* dst = Op + (size_t)(w * 32 + qg * 16 + l15) * 1024 + quad * 4;
#pragma unroll
    for (int dg = 0; dg < 4; dg++) {
      uint2 v;
      v.x = pack2(o[dg][qg][0] * inv, o[dg][qg][1] * inv);
      v.y = pack2(o[dg][qg][2] * inv, o[dg][qg][3] * inv);
      *(uint2*)(dst + dg * 16) = v;
    }
  }
}
#undef KOFF
#undef VOFF

DEV void conv_tile(const float* __restrict__ src, int K, int N, u16* __restrict__ dst, int kt, int nt, float* lds, const float* __restrict__ kscale) {
  const int tid = opaque_tid();
  __syncthreads();
  {
    float4 v[4];
    const int n4 = (tid & 15) * 4;
    const int gn = nt * 64 + n4;
#pragma unroll
    for (int i = 0; i < 4; i++) {
      const int k = i * 16 + (tid >> 4);
      v[i] = (gn < N) ? *(const float4*)(src + (size_t)(kt * 64 + k) * N + gn) : make_float4(0.f, 0.f, 0.f, 0.f);
      if (kscale) { const float ks = kscale[kt * 64 + k]; v[i].x *= ks; v[i].y *= ks; v[i].z *= ks; v[i].w *= ks; }
    }
#pragma unroll
    for (int i = 0; i < 4; i++) {
      const int k = i * 16 + (tid >> 4);
      float* d = lds + k * 65 + n4;
      d[0] = v[i].x; d[1] = v[i].y; d[2] = v[i].z; d[3] = v[i].w;
    }
  }
  __syncthreads();
#pragma unroll
  for (int i = 0; i < 2; i++) {
    const int c = tid + i * 256;
    const int nn = c >> 3, k8 = (c & 7) * 8;
    float f[8];
#pragma unroll
    for (int e = 0; e < 8; e++) f[e] = lds[(k8 + e) * 65 + nn];
    store8(dst + (size_t)(nt * 64 + nn) * K + kt * 64 + k8, f);
  }
}

constexpr int NCT = 4272;

DEV void phase0(const Params& p, int vb, int G, char* smem) {
  float* ldsf = (float*)smem;
  const int tid = opaque_tid();
  const int total = 2 * NCT + 128 + 192 + 1;
  for (int it0 = vb; it0 < total; it0 += G) {
    const int it = (it0 < 192) ? (2 * NCT + 128 + it0) : ((it0 < 192 + 2 * NCT + 128) ? (it0 - 192) : it0);
    if (it < 2 * NCT) {
      const int l = it / NCT;
      int idx = it - l * NCT;
      u16* W = (u16*)(p.ws + WS_W) + (size_t)l * WL;
      const float* src; u16* dst; int K, N, kt, nt; const float* kscale = nullptr;
      if (idx < 576) { K = 1024; N = 2272; nt = idx >> 4; kt = idx & 15; src = p.in[6] + (size_t)l * 1024 * 2272; dst = W + OW_IN; }
      else if ((idx -= 576) < 1024) { int i = idx >> 8, r = idx & 255; K = 1024; N = 1024; nt = r >> 4; kt = r & 15; src = p.in[22] + (size_t)(l * 4 + i) * 1048576; dst = W + OW_GATE + (size_t)i * 1048576; }
      else if ((idx -= 1024) < 256) { int i = idx >> 6, r = idx & 63; K = 256; N = 1024; nt = r >> 2; kt = r & 3; src = p.in[21] + (size_t)(l * 4 + i) * 262144; dst = W + OW_BRANCH + (size_t)i * 262144; }
      else if ((idx -= 256) < 256) { K = 1024; N = 1024; nt = idx >> 4; kt = idx & 15; src = p.in[24] + (size_t)l * 1048576; dst = W + OW_OUT; }
      else if ((idx -= 256) < 1408) { K = 1024; N = 5632; nt = idx >> 4; kt = idx & 15; src = p.in[25] + (size_t)l * 1024 * 5632; dst = W + OW_UP; }
      else if ((idx -= 1408) < 704) { K = 2816; N = 1024; nt = idx / 44; kt = idx % 44; src = p.in[28] + (size_t)l * 2816 * 1024; dst = W + OW_DOWN; }
      else if ((idx -= 704) < 24) { K = 256; N = 384; nt = idx >> 2; kt = idx & 3; src = p.in[12] + (size_t)l * 256 * 384; dst = W + OW_UQ; kscale = p.in[10] + l * 256; }
      else { idx -= 24; K = 192; N = 512; nt = idx / 3; kt = idx % 3; src = p.in[13] + (size_t)l * 192 * 512; dst = W + OW_UKV; kscale = p.in[11] + l * 192; }
      conv_tile(src, K, N, dst, kt, nt, ldsf, kscale);
    } else if (it < 2 * NCT + 128) {
      const int j = it - 2 * NCT;
      const int l = j >> 6, ch = j & 63;
      const float* src = p.in[17] + (size_t)l * 65536 + ch * 1024;
      u16* dst = (u16*)(p.ws + WS_W) + (size_t)l * WL + OW_SG + ch * 1024;
      float4 v = *(const float4*)(src + tid * 4);
      uint2 o; o.x = pack2(v.x, v.y); o.y = pack2(v.z, v.w);
      *(uint2*)(dst + tid * 4) = o;
    } else if (it < 2 * NCT + 128 + 192) {
      const int j = it - (2 * NCT + 128);
      const int l = j / 96, cb = j % 96;
      __syncthreads();
      float* sc = ldsf;
      float* red = ldsf + 5120;
      for (int i = tid; i < 5120; i += 256) {
        int m = i >> 10, k = i & 1023;
        float c = (m < 4) ? p.in[1][m * 1024 + k] : p.in[3][k];
        sc[i] = silu_f(c);
      }
      __syncthreads();
      const int kg = tid >> 6, n = tid & 63;
      const float* wsrc = p.in[4] + (size_t)l * 1024 * 6144 + cb * 64 + n;
      float a0 = 0, a1 = 0, a2 = 0, a3 = 0, a4 = 0;
#pragma unroll 8
      for (int k = kg * 256; k < kg * 256 + 256; k++) {
        float wv = wsrc[(size_t)k * 6144];
        a0 += sc[k] * wv; a1 += sc[1024 + k] * wv; a2 += sc[2048 + k] * wv; a3 += sc[3072 + k] * wv; a4 += sc[4096 + k] * wv;
      }
      red[(kg * 5 + 0) * 64 + n] = a0; red[(kg * 5 + 1) * 64 + n] = a1; red[(kg * 5 + 2) * 64 + n] = a2;
      red[(kg * 5 + 3) * 64 + n] = a3; red[(kg * 5 + 4) * 64 + n] = a4;
      __syncthreads();
      for (int i = tid; i < 320; i += 256) {
        int m = i >> 6, nn = i & 63;
        float v = red[(0 * 5 + m) * 64 + nn] + red[(1 * 5 + m) * 64 + nn] + red[(2 * 5 + m) * 64 + nn] + red[(3 * 5 + m) * 64 + nn];
        v += p.in[5][(size_t)l * 6144 + cb * 64 + nn];
        ((float*)(p.ws + WS_MOD))[(size_t)(l * 5 + m) * 6144 + cb * 64 + nn] = v;
      }
    } else {
      float2* r16 = (float2*)(p.ws + WS_R16);
      float2* r8 = (float2*)(p.ws + WS_R8);
      for (int i = tid; i < 1024; i += 256) ((unsigned*)(p.ws + WS_ZROW))[i] = 0u;
      if (tid < 64) {
        const int lane = tid;
        auto amax = [&](const float* v, int lo, int hi) {
          float m = 0.f;
          for (int i = lo + lane; i < hi; i += 64) m = fmaxf(m, fabsf(v[i]));
#pragma unroll
          for (int o = 32; o >= 1; o >>= 1) m = fmaxf(m, shfl_xor_f(m, o));
          return m;
        };
        for (int l = 0; l < 2; l++) {
          const float naq = amax(p.in[7] + l * 64, 0, 64), nak = amax(p.in[8] + l * 64, 0, 64);
          const float gqq = amax(p.in[19] + l * 64, 0, 64), gqk = amax(p.in[20] + l * 64, 0, 64);
          const float mq1 = amax(p.in[14] + l * 96, 0, 64), mq2 = amax(p.in[14] + l * 96, 64, 96);
          const float mk1 = amax(p.in[15] + l * 96, 0, 64), mk2 = amax(p.in[15] + l * 96, 64, 96);
          const float rb = amax(p.in[9] + (size_t)l * 4 * 465, 0, 4 * 465);
          if (lane == 0) {
            float* mr = (float*)(p.ws + WS_MREF) + l * 4;
            mr[0] = sqrtf(64.f * mq1 * mq1 + 32.f * mq2 * mq2) * sqrtf(64.f * mk1 * mk1 + 32.f * mk2 * mk2) * 0.10206207261596575f * LOG2E;
            mr[1] = 8.f * gqq * 8.f * gqk * 0.125f * LOG2E;
            mr[2] = (8.f * naq * 8.f * nak * 0.125f + rb) * LOG2E;
          }
        }
      }
      for (int i = tid; i < 2048; i += 256) {
        int pos = i >> 4, k = i & 15;
        float inv = powf(10000.f, -(float)k / 16.f);
        float ang = (float)pos * inv;
        r16[i] = make_float2(cosf(ang), sinf(ang));
      }
      for (int i = tid; i < 1024; i += 256) {
        int pos = i >> 3, k = i & 7;
        float inv = powf(10000.f, -(float)k / 8.f);
        float ang = (float)pos * inv;
        r8[i] = make_float2(cosf(ang), sinf(ang));
      }
    }
  }
}

DEV void phase_modulate(const XMap& xin, const float* __restrict__ modl, int shi, int sci, u16* __restrict__ H,
                        bool skip_ctx, int vb, int G) {
  const int tid = opaque_tid(), lane = tid & 63, w = tid >> 6;
  for (int m = vb * 4 + w; m < MM; m += G * 4) {
    const int b = m / SS, s = m - b * SS;
    if (skip_ctx && s < CC) continue;
    const int mrow = (s < CC) ? 4 : b;
    const float* xr = xrow(xin, m);
    float4 v[4];
    float ss = 0.f;
#pragma unroll
    for (int i = 0; i < 4; i++) {
      v[i] = *(const float4*)(xr + i * 256 + lane * 4);
      ss += v[i].x * v[i].x + v[i].y * v[i].y + v[i].z * v[i].z + v[i].w * v[i].w;
    }
#pragma unroll
    for (int o = 32; o >= 1; o >>= 1) ss += shfl_xor_f(ss, o);
    const float rstd = rsqrtf(ss * (1.f / 1024.f) + EPS);
    const float* sh = modl + (size_t)mrow * 6144 + shi * 1024;
    const float* sc = modl + (size_t)mrow * 6144 + sci * 1024;
#pragma unroll
    for (int i = 0; i < 4; i++) {
      const int n = i * 256 + lane * 4;
      float4 a = *(const float4*)(sc + n);
      float4 c = *(const float4*)(sh + n);
      uint2 o;
      o.x = pack2(v[i].x * rstd * (1.f + a.x) + c.x, v[i].y * rstd * (1.f + a.y) + c.y);
      o.y = pack2(v[i].z * rstd * (1.f + a.z) + c.z, v[i].w * rstd * (1.f + a.w) + c.w);
      *(uint2*)(H + (size_t)m * DD + n) = o;
    }
  }
}

DEV void unpack8(const u32x4& v, float (&f)[8]) {
  f[0] = __uint_as_float(v[0] << 16); f[1] = __uint_as_float(v[0] & 0xffff0000u);
  f[2] = __uint_as_float(v[1] << 16); f[3] = __uint_as_float(v[1] & 0xffff0000u);
  f[4] = __uint_as_float(v[2] << 16); f[5] = __uint_as_float(v[2] & 0xffff0000u);
  f[6] = __uint_as_float(v[3] << 16); f[7] = __uint_as_float(v[3] & 0xffff0000u);
}

DEV void head_norm64(float (&v)[8], const float* __restrict__ gain, int c, bool rope, int s, const float2* __restrict__ R16) {
  float ss = 0.f;
#pragma unroll
  for (int e = 0; e < 8; e++) ss += v[e] * v[e];
  ss += shfl_xor_f(ss, 1); ss += shfl_xor_f(ss, 2); ss += shfl_xor_f(ss, 4);
  const float rstd = rsqrtf(ss * (1.f / 64.f) + EPS);
#pragma unroll
  for (int e = 0; e < 8; e++) v[e] *= rstd * gain[c * 8 + e];
  if (rope) {
    const int tl = s - CC;
    const int pos = (c & 4) ? (tl & 63) : (tl >> 6);
#pragma unroll
    for (int e = 0; e < 8; e++) {
      float pr = shfl_xor_f(v[e], 2);
      float2 cs = R16[pos * 16 + (c & 1) * 8 + e];
      v[e] = (c & 2) ? (v[e] * cs.x + pr * cs.y) : (v[e] * cs.x - pr * cs.y);
    }
  }
}

DEV void prep_item(const Params& p, int l, int it, char* smem) {
  u16* Z = (u16*)(p.ws + WS_Z);
  u16* QKV = (u16*)(p.ws + WS_QKV);
  const float2* R16 = (const float2*)(p.ws + WS_R16);
  const float2* R8 = (const float2*)(p.ws + WS_R8);
  float* rstd_l = (float*)smem;
  const float* na_qn = p.in[7] + l * 64;
  const float* na_kn = p.in[8] + l * 64;
  const float* cq_n = p.in[10] + l * 256;
  const float* ckv_n = p.in[11] + l * 192;
  const float* mla_kn = p.in[15] + l * 96;
  const float* sgv_n = p.in[16] + l * 256;
  const float* gq_qn = p.in[19] + l * 64;
  const float* gq_kn = p.in[20] + l * 64;
  {
    const int tid = opaque_tid(), lane = tid & 63, w = tid >> 6;
    const int part = it % 3;
    const int m0 = (it / 3) * 64;
    const int b = m0 / SS, s0 = m0 - b * SS;
    const bool latent = (s0 >= CC);
    if (part == 0) {
      const int c = tid & 7;
#pragma unroll
      for (int g = 0; g < 2; g++) {
        u32x4 raw[4][2];
#pragma unroll
        for (int h = 0; h < 4; h++)
#pragma unroll
          for (int rep = 0; rep < 2; rep++)
            raw[h][rep] = *(const u32x4*)(Z + (size_t)(m0 + rep * 32 + (tid >> 3)) * ZW + g * 256 + h * 64 + c * 8);
        const float* gain = g ? na_kn : na_qn;
#pragma unroll
        for (int h = 0; h < 4; h++)
#pragma unroll
          for (int rep = 0; rep < 2; rep++) {
            const int s = s0 + rep * 32 + (tid >> 3);
            float v[8];
            unpack8(raw[h][rep], v);
            head_norm64(v, gain, c, false, s, R16);
            store8(QKV + (g ? K_NA : Q_NA) + ((size_t)(b * 4 + h) * SS + s) * 64 + c * 8, v);
          }
      }
    } else if (part == 1) {
      const int c = tid & 7;
      {
        u32x4 raw[6][2];
#pragma unroll
        for (int h = 0; h < 6; h++)
#pragma unroll
          for (int rep = 0; rep < 2; rep++)
            raw[h][rep] = *(const u32x4*)(Z + (size_t)(m0 + rep * 32 + (tid >> 3)) * ZW + 1760 + h * 64 + c * 8);
#pragma unroll
        for (int h = 0; h < 6; h++)
#pragma unroll
          for (int rep = 0; rep < 2; rep++) {
            const int s = s0 + rep * 32 + (tid >> 3);
            float v[8];
            unpack8(raw[h][rep], v);
            head_norm64(v, (h < 4) ? gq_qn : gq_kn, c, latent, s, R16);
            u16* dst = (h < 4) ? (QKV + Q_GQA + ((size_t)(b * 4 + h) * SS + s) * 64) : (QKV + K_GQA + ((size_t)(b * 2 + (h - 4)) * SS + s) * 64);
            store8(dst + c * 8, v);
          }
      }
      const int sp = perm32(s0 + lane);
#pragma unroll
      for (int k3 = 0; k3 < 3; k3++) {
        u32x4 raw[4];
#pragma unroll
        for (int q = 0; q < 4; q++) {
          const int ct = w + 4 * (k3 * 4 + q);
          const int srccol = (ct < 32) ? (512 + ct * 8) : (2144 + (ct - 32) * 8);
          raw[q] = *(const u32x4*)(Z + (size_t)(m0 + lane) * ZW + srccol);
        }
#pragma unroll
        for (int q = 0; q < 4; q++) {
          const int ct = w + 4 * (k3 * 4 + q);
          u16* dst;
          if (ct < 32) { int head = ct >> 3, dv0 = (ct & 7) * 8; dst = QKV + V_NA + ((size_t)(b * 4 + head) * 64 + dv0) * SS; }
          else { int cg2 = ct - 32; int head = cg2 >> 3, dv0 = (cg2 & 7) * 8; dst = QKV + V_GQA + ((size_t)(b * 2 + head) * 64 + dv0) * SS; }
          dst += sp;
#pragma unroll
          for (int e = 0; e < 4; e++) {
            dst[(size_t)(2 * e) * SS] = (u16)(raw[q][e] & 0xffff);
            dst[(size_t)(2 * e + 1) * SS] = (u16)(raw[q][e] >> 16);
          }
        }
      }
    } else if (part == 2) {
      __syncthreads();
#pragma unroll
      for (int hb = 0; hb < 2; hb++) {
        u32x4 ru[4], rv2[4];
#pragma unroll
        for (int q = 0; q < 4; q++) {
          const int idx = (hb * 4 + q) * 256 + tid;
          const int t = idx >> 5, c = idx & 31;
          ru[q] = *(const u32x4*)(Z + (size_t)(m0 + t) * ZW + 1248 + c * 8);
          rv2[q] = *(const u32x4*)(Z + (size_t)(m0 + t) * ZW + 1504 + c * 8);
        }
#pragma unroll
        for (int q = 0; q < 4; q++) {
          const int idx = (hb * 4 + q) * 256 + tid;
          const int t = idx >> 5, c = idx & 31;
          float v[8];
          unpack8(ru[q], v);
#pragma unroll
          for (int e = 0; e < 8; e++) v[e] = gelu_f(v[e]);
          store8(QKV + SG_U + (size_t)(m0 + t) * 256 + c * 8, v);
          unpack8(rv2[q], v);
          float ss = 0.f;
#pragma unroll
          for (int e = 0; e < 8; e++) { float g = gelu_f(v[e]); ss += g * g; }
#pragma unroll
          for (int o = 1; o <= 16; o <<= 1) ss += shfl_xor_f(ss, o);
          if (c == 0) rstd_l[t] = rsqrtf(ss * (1.f / 256.f) + EPS);
        }
      }
      __syncthreads();
      {
        u32x4 raw[8];
#pragma unroll
        for (int q = 0; q < 8; q++) raw[q] = *(const u32x4*)(Z + (size_t)(m0 + lane) * ZW + 1504 + (w + 4 * q) * 8);
        const float rs = rstd_l[lane];
        const int mm = m0 + lane;
#pragma unroll
        for (int q = 0; q < 8; q++) {
          const int ct = w + 4 * q;
          float v[8];
          unpack8(raw[q], v);
          u16* dst = QKV + SG_VT + (size_t)(mm >> 7) * 32768 + (size_t)(ct * 8) * 128 + (mm & 127);
#pragma unroll
          for (int e = 0; e < 8; e++) dst[e * 128] = f2bf(gelu_f(v[e]) * rs * sgv_n[ct * 8 + e]);
        }
      }
    }
  }
}

#define XB_TMO      128
#define XB_XCNT(j)  (256  + 64 * (j))
#define XB_XSUB(j)  (1280 + 64 * (j))
#define XB_XGEN(j)  (2304 + 64 * (j))
#define XB_TOP      3328
#define XB_TOPGEN   3392
#define XCD_BAR_WORDS 3456
#define XB_SPIN_CAP (1u << 18)
#define LAS __attribute__((address_space(3)))

__device__ __forceinline__ unsigned xb_ld(unsigned* p)              { return __hip_atomic_load(p, __ATOMIC_RELAXED, __HIP_MEMORY_SCOPE_AGENT); }
__device__ __forceinline__ unsigned xb_add(unsigned* p, unsigned v) { return __hip_atomic_fetch_add(p, v, __ATOMIC_RELAXED, __HIP_MEMORY_SCOPE_AGENT); }
__device__ __forceinline__ unsigned xb_xcc_id() { return (unsigned)__builtin_amdgcn_s_getreg((3 << 11) | 20) & 0xFu; }
#define XB_SPIN(cond, bar) do { unsigned _sp = 0; while (cond) { __builtin_amdgcn_s_sleep(1); \
    if ((++_sp & 255u) == 0u) { if (xb_ld(&(bar)[XB_TMO])) break; if (_sp > XB_SPIN_CAP) { atomicAdd(&(bar)[XB_TMO], 1u); break; } } } } while (0)

struct XcdBarrier {
    unsigned* bar; unsigned x;
    volatile LAS unsigned* st;
};

__device__ __forceinline__ XcdBarrier xcd_barrier_post(unsigned* bar, volatile LAS unsigned* st) {
    XcdBarrier b; b.bar = bar; b.x = (unsigned)__builtin_amdgcn_readfirstlane((int)xb_xcc_id()); b.st = st;
    if (threadIdx.x == 0) (void)xb_add(&bar[XB_XCNT(b.x)], 1u);
    return b;
}
__device__ __forceinline__ void xcd_barrier_complete(unsigned* bar, unsigned x, unsigned& nloc, unsigned& nx) {
    const unsigned G = gridDim.x * gridDim.y * gridDim.z;
    unsigned sum, cnt, mine, sp = 0u;
    for (;;) {
        sum = 0u; cnt = 0u; mine = 0u;
#pragma unroll
        for (unsigned j = 0; j < 16; ++j) { const unsigned c = xb_ld(&bar[XB_XCNT(j)]); sum += c; cnt += (c > 0u) ? 1u : 0u; mine = (j == x) ? c : mine; }
        if (sum == G) break;
        __builtin_amdgcn_s_sleep(1);
        if ((++sp & 255u) == 0u) { if (xb_ld(&bar[XB_TMO])) break; if (sp > XB_SPIN_CAP) { atomicAdd(&bar[XB_TMO], 1u); break; } }
    }
    nloc = mine > 0u ? mine : 1u; nx = cnt > 0u ? cnt : 1u;
}

__device__ __forceinline__ void xcd_barrier(const XcdBarrier& b) {
    asm volatile("s_waitcnt vmcnt(0)" ::: "memory");
    __syncthreads();
    if (threadIdx.x == 0) {
        unsigned* bar = b.bar;
        __builtin_amdgcn_s_waitcnt(0);
        unsigned nloc = b.st[0], nx = b.st[1];
        if (nloc == 0u) { xcd_barrier_complete(bar, b.x, nloc, nx); b.st[0] = nloc; b.st[1] = nx; }
        const unsigned old = xb_add(&bar[XB_XSUB(b.x)], 1u);
        const unsigned gen = old / nloc;
        if (old + 1u == (gen + 1u) * nloc) {
            __builtin_amdgcn_fence(__ATOMIC_RELEASE, "agent");
            asm volatile("s_waitcnt vmcnt(0)" ::: "memory");
            const unsigned og = xb_add(&bar[XB_TOP], 1u);
            const unsigned tg = og / nx;
            if (og + 1u == (tg + 1u) * nx) xb_add(&bar[XB_TOPGEN], 1u);
            else XB_SPIN(xb_ld(&bar[XB_TOPGEN]) == tg, bar);
            __builtin_amdgcn_fence(__ATOMIC_ACQUIRE, "agent");
            xb_add(&bar[XB_XGEN(b.x)], 1u);
            asm volatile("s_waitcnt vmcnt(0)" ::: "memory");
        } else {
            XB_SPIN(xb_ld(&bar[XB_XGEN(b.x)]) == gen, bar);
            __builtin_amdgcn_fence(__ATOMIC_ACQUIRE, "agent");
            asm volatile("s_waitcnt vmcnt(0)" ::: "memory");
        }
    }
    __syncthreads();
}


__global__ void __launch_bounds__(256, 2) fwd_megakernel(Params p) {
  __shared__ __attribute__((aligned(16))) char smem[SMEM_BYTES];
  cg::grid_group grid = cg::this_grid();
  __shared__ __attribute__((aligned(16))) unsigned xb_st[4];
  if (threadIdx.x < 4) xb_st[threadIdx.x] = 0u;
  __syncthreads();
  XcdBarrier xbar = xcd_barrier_post((unsigned*)(p.ws + WS_BAR), (volatile LAS unsigned*)xb_st);
  const int G = gridDim.x;
  const int vb = ((G & 7) == 0) ? ((blockIdx.x & 7) * (G >> 3) + (blockIdx.x >> 3)) : (int)blockIdx.x;
  const int tid = opaque_tid(), lane = tid & 63, w = tid >> 6, l15 = lane & 15, quad = lane >> 4;
  const int wm = w >> 1, wn = w & 1;
  u16* ldsu = (u16*)smem;
  float* ldsf = (float*)smem;

  u16* H = (u16*)(p.ws + WS_H);
  u16* Z = (u16*)(p.ws + WS_Z);
  u16* O = Z;
  u16* Y = Z + (size_t)MM * 1024;
  u16* QKV = (u16*)(p.ws + WS_QKV);
  u16* ACT = QKV;
  const float2* R8 = (const float2*)(p.ws + WS_R8);

  for (int rep_ = 0; rep_ < REP_SYNC; rep_++) grid.sync();
#ifndef SKIP_P0
  for (int rep_ = 0; rep_ < REP_P0; rep_++) phase0(p, vb, G, smem);
#endif
  if (gridDim.y > 1) grid.sync();

  for (int l = 0; l < 2; l++) {
    xcd_barrier(xbar);
    const u16* W = (const u16*)(p.ws + WS_W) + (size_t)l * WL;
    const float* modl = (const float*)(p.ws + WS_MOD) + (size_t)l * 5 * 6144;
    XMap xin, xout;
    if (l == 0) { xin.lat = (float*)p.in[0]; xin.ctx = (float*)p.in[2]; }
    else { xin.lat = p.out; xin.ctx = (float*)(p.ws + WS_CX); }
    xout.lat = p.out; xout.ctx = (float*)(p.ws + WS_CX);
    const bool last = (l == 1);

#ifndef SKIP_P1
    for (int rep_ = 0; rep_ < REP_P1; rep_++) {
    phase_modulate(xin, modl, 0, 1, H, false, vb, G);
    }
#endif
    xcd_barrier(xbar);

#ifndef SKIP_P2
    {
    for (int rep_ = 0; rep_ < REP_P2; rep_++) {
    const int tid = opaque_tid(), lane = tid & 63, w = tid >> 6, l15 = lane & 15, quad = lane >> 4;
    const int wm = w >> 1, wn = w & 1;
    (void)wm; (void)wn; (void)l15; (void)quad;
    for (int it = vb; it < 264 * 9; it += G) {
      const int g8 = it / (8 * 9);
      const int rem = it - g8 * (8 * 9);
      const int nt = rem >> 3;
      const int mt = g8 * 8 + (rem & 7);
      const int m0 = mt * 128, n0 = nt * 256;
      f32x4 acc[4][8];
      gemm_wide([&](int r) { return (const u16*)(H + (size_t)(m0 + r) * DD); },
                [&](int n) { return (const u16*)(W + OW_IN + (size_t)(n0 + n) * 1024); }, 32, acc, ldsu);
      const int tid = opaque_tid(), lane = tid & 63, w = tid >> 6, l15 = lane & 15, quad = lane >> 4, wm = w >> 1, wn = w & 1; (void)lane; (void)wm; (void)wn; (void)l15; (void)quad;
      u16* zb = Z + (size_t)m0 * ZW + n0;
#pragma unroll
      for (int i = 0; i < 4; i++)
#pragma unroll
        for (int j = 0; j < 8; j++)
#pragma unroll
          for (int e = 0; e < 4; e++) zb[ACC_ROW(i, e) * ZW + ACC_COLW(j)] = f2bf(acc[i][j][e]);
    }
    }
    }
#endif
    xcd_barrier(xbar);

#ifndef SKIP_P4
    {
    for (int rep_ = 0; rep_ < REP_P4; rep_++) {
    const int tid = opaque_tid(), lane = tid & 63, w = tid >> 6, l15 = lane & 15, quad = lane >> 4;
    const int wm = w >> 1, wn = w & 1;
    (void)wm; (void)wn; (void)l15; (void)quad;
    {
      const float* mla_qn = p.in[14] + l * 96;
      const float* mla_kn = p.in[15] + l * 96;
      for (int it = vb; it < 264 * 8 + (MM / 64) * 3; it += G) {
        if (it >= 264 * 8) { prep_item(p, l, it - 264 * 8, smem); continue; }
        const int mt = it >> 3, hh = it & 7;
        if (last && hh < 4 && (mt % 66) < 2) continue;
        const int m0 = mt * 128;
        const int b = m0 / SS, s0 = m0 - b * SS;
        if (hh < 4) {
          const int h = hh;
          f32x4 acc[4][3];
          gemm_core<96>([&](int r) { return (const u16*)(Z + (size_t)(m0 + r) * ZW + 768); },
                        [&](int n) { return (const u16*)(W + OW_UQ + (size_t)(h * 96 + n) * 256); }, 4, acc, ldsu);
      const int tid = opaque_tid(), lane = tid & 63, w = tid >> 6, l15 = lane & 15, quad = lane >> 4, wm = w >> 1, wn = w & 1; (void)lane; (void)wm; (void)wn; (void)l15; (void)quad;
          acc_to_lds<96>(acc, ldsf);
          __syncthreads();
          const int t = tid >> 1, hs = tid & 1;
          const int s = s0 + t;
          u16* dst = QKV + Q_MLA + ((size_t)(b * 4 + h) * SS + s) * 96;
          const float* st = ldsf + t * 97;
          float rq;
          {
            const u16* zr = Z + (size_t)(m0 + t) * ZW + 768 + hs * 128;
            u32x4 raw[16];
#pragma unroll
            for (int c = 0; c < 16; c++) raw[c] = *(const u32x4*)(zr + c * 8);
            float sq = 0.f;
#pragma unroll
            for (int c = 0; c < 16; c++) {
              float v[8];
              unpack8(raw[c], v);
#pragma unroll
              for (int e = 0; e < 8; e++) sq += v[e] * v[e];
            }
            sq += shfl_xor_f(sq, 1);
            rq = rsqrtf(sq * (1.f / 256.f) + EPS);
          }
          if (hs == 0) {
            float ss = 0.f;
#pragma unroll
            for (int e = 0; e < 64; e++) ss += st[e] * st[e];
            ss *= rq * rq;
            const float rstd = rq * rsqrtf(ss * (1.f / 64.f) + EPS);
#pragma unroll
            for (int c = 0; c < 8; c++) {
              float v[8];
#pragma unroll
              for (int e = 0; e < 8; e++) v[e] = st[c * 8 + e] * rstd * mla_qn[c * 8 + e];
              store8(dst + c * 8, v);
            }
          } else {
            float ss = 0.f;
#pragma unroll
            for (int e = 0; e < 32; e++) ss += st[64 + e] * st[64 + e];
            ss *= rq * rq;
            const float rstd = rq * rsqrtf(ss * (1.f / 32.f) + EPS);
            float x1[8], x2[8], y1[8], y2[8];
#pragma unroll
            for (int e = 0; e < 8; e++) {
              x1[e] = st[64 + e] * rstd * mla_qn[64 + e];
              x2[e] = st[72 + e] * rstd * mla_qn[72 + e];
              y1[e] = st[80 + e] * rstd * mla_qn[80 + e];
              y2[e] = st[88 + e] * rstd * mla_qn[88 + e];
            }
            if (s >= CC) {
              const int tl = s - CC;
              const int prow = tl >> 6, pcol = tl & 63;
#pragma unroll
              for (int e = 0; e < 8; e++) {
                float2 cr = R8[prow * 8 + e];
                float2 cc = R8[pcol * 8 + e];
                float a1 = x1[e] * cr.x - x2[e] * cr.y;
                float a2 = x2[e] * cr.x + x1[e] * cr.y;
                float b1 = y1[e] * cc.x - y2[e] * cc.y;
                float b2 = y2[e] * cc.x + y1[e] * cc.y;
                x1[e] = a1; x2[e] = a2; y1[e] = b1; y2[e] = b2;
              }
            }
            store8(dst + 64, x1); store8(dst + 72, x2); store8(dst + 80, y1); store8(dst + 88, y2);
          }
        } else {
          const int h = hh - 4;
          f32x4 acc[4][4];
          gemm_core<128>([&](int r) { return (const u16*)(Z + (size_t)(m0 + r) * ZW + 1024); },
                         [&](int n) { return (const u16*)(W + OW_UKV + (size_t)(h * 128 + n) * 192); }, 3, acc, ldsu);
      const int tid = opaque_tid(), lane = tid & 63, w = tid >> 6, l15 = lane & 15, quad = lane >> 4, wm = w >> 1, wn = w & 1; (void)lane; (void)wm; (void)wn; (void)l15; (void)quad;
          acc_to_lds<128>(acc, ldsf);
          __syncthreads();
          float* rs_l = ldsf + 128 * 129;
          {
            const int t = tid >> 1, hs = tid & 1;
            const int s = s0 + t;
            float rkv;
            {
              const u16* zr = Z + (size_t)(m0 + t) * ZW + 1024 + hs * 96;
              u32x4 raw[12];
#pragma unroll
              for (int c = 0; c < 12; c++) raw[c] = *(const u32x4*)(zr + c * 8);
              float sq = 0.f;
#pragma unroll
              for (int c = 0; c < 12; c++) {
                float v[8];
                unpack8(raw[c], v);
#pragma unroll
                for (int e = 0; e < 8; e++) sq += v[e] * v[e];
              }
              sq += shfl_xor_f(sq, 1);
              rkv = rsqrtf(sq * (1.f / 192.f) + EPS);
            }
            if (hs == 1) {
              float x1[8], x2[8], y1[8], y2[8];
              const u16* zk = Z + (size_t)(m0 + t) * ZW + 1216;
              load8(zk, x1); load8(zk + 8, x2); load8(zk + 16, y1); load8(zk + 24, y2);
              float ssr = 0.f;
#pragma unroll
              for (int e = 0; e < 8; e++) ssr += x1[e] * x1[e] + x2[e] * x2[e] + y1[e] * y1[e] + y2[e] * y2[e];
              const float rr = rsqrtf(ssr * (1.f / 32.f) + EPS);
#pragma unroll
              for (int e = 0; e < 8; e++) {
                x1[e] *= rr * mla_kn[64 + e]; x2[e] *= rr * mla_kn[72 + e];
                y1[e] *= rr * mla_kn[80 + e]; y2[e] *= rr * mla_kn[88 + e];
              }
              if (s >= CC) {
                const int tl = s - CC;
                const int prow = tl >> 6, pcol = tl & 63;
#pragma unroll
                for (int e = 0; e < 8; e++) {
                  const float2 cr = R8[prow * 8 + e];
                  const float2 cc2 = R8[pcol * 8 + e];
                  const float a1 = x1[e] * cr.x - x2[e] * cr.y;
                  const float a2 = x2[e] * cr.x + x1[e] * cr.y;
                  const float b1 = y1[e] * cc2.x - y2[e] * cc2.y;
                  const float b2 = y2[e] * cc2.x + y1[e] * cc2.y;
                  x1[e] = a1; x2[e] = a2; y1[e] = b1; y2[e] = b2;
                }
              }
              u16* dstr = QKV + K_MLA + ((size_t)(b * 4 + h) * SS + s) * 96 + 64;
              store8(dstr, x1); store8(dstr + 8, x2); store8(dstr + 16, y1); store8(dstr + 24, y2);
            }
            if (hs == 0) {
              rs_l[t] = rkv;
              const float* st = ldsf + t * 129;
              float ss = 0.f;
#pragma unroll
              for (int e = 0; e < 64; e++) ss += st[e] * st[e];
              ss *= rkv * rkv;
              const float rstd = rkv * rsqrtf(ss * (1.f / 64.f) + EPS);
              u16* dst = QKV + K_MLA + ((size_t)(b * 4 + h) * SS + s) * 96;
#pragma unroll
              for (int c = 0; c < 8; c++) {
                float v[8];
#pragma unroll
                for (int e = 0; e < 8; e++) v[e] = st[c * 8 + e] * rstd * mla_kn[c * 8 + e];
                store8(dst + c * 8, v);
              }
            }
          }
          __syncthreads();
          {
            const int t = tid & 127, half = tid >> 7;
            const int sp = perm32(s0 + t);
            u16* dst = QKV + V_MLA + ((size_t)(b * 4 + h) * 64 + half * 32) * SS + sp;
            const float* st = ldsf + t * 129 + 64 + half * 32;
            const float rkv = rs_l[t];
#pragma unroll 8
            for (int e = 0; e < 32; e++) dst[(size_t)e * SS] = f2bf(st[e] * rkv);
          }
        }
      }
    }
    }
    }
#endif
    xcd_barrier(xbar);

#ifndef SKIP_P6
    {
    for (int rep_ = 0; rep_ < REP_P6; rep_++) {
    const int tid = opaque_tid(), lane = tid & 63, w = tid >> 6, l15 = lane & 15, quad = lane >> 4;
    const int wm = w >> 1, wn = w & 1;
    (void)wm; (void)wn; (void)l15; (void)quad;
    {
      const float sc_mla = 0.10206207261596575f * LOG2E;
      const float sc_64 = 0.125f * LOG2E;
      float* rpb_lds = (float*)(smem + 49152);
      const float* rpb = p.in[9] + (size_t)l * 4 * 465;
      const float* sgb = p.in[18] + (size_t)l * 512;
      const int nctx = last ? 0 : 96;
      const float* mrp = (const float*)(p.ws + WS_MREF) + l * 4;
      const float mref_mla = mrp[0], mref_gqa = mrp[1], mref_na = mrp[2];
      const int total = 1024 + 1024 + 1024 + 1056 + nctx;
      for (int it = vb; it < total; it += G) {
        int kind;
        const u16* Qp = nullptr; const u16* Kp = nullptr; const u16* Vp = nullptr; u16* Op = nullptr;
        int q0 = 0, t0 = 0, n0 = 0, t1 = 0, n1 = 0, r0 = 0, hsel = 0;
        int sg_ec = 0, sg_g = 0;
        float mref1 = mref_gqa;
        if (it < 3072) {
          const int typ = it >> 10;
          const int j = it & 1023;
          const int qt = j & 63, h = (j >> 6) & 3, b = j >> 8;
          q0 = CC + qt * 128;
          hsel = h;
          if (typ == 0) {
            kind = 0;
            Qp = QKV + Q_MLA + (size_t)(b * 4 + h) * SS * 96; Kp = QKV + K_MLA + (size_t)(b * 4 + h) * SS * 96;
            Vp = QKV + V_MLA + (size_t)(b * 4 + h) * 64 * SS; Op = O + (size_t)(b * SS + q0) * 1024 + 256 + h * 64;
            t0 = 0; n0 = 132;
          } else if (typ == 1) {
            kind = 1;
            const int g = h >> 1;
            Qp = QKV + Q_GQA + (size_t)(b * 4 + h) * SS * 64; Kp = QKV + K_GQA + (size_t)(b * 2 + g) * SS * 64;
            Vp = QKV + V_GQA + (size_t)(b * 2 + g) * 64 * SS; Op = O + (size_t)(b * SS + q0) * 1024 + 768 + h * 64;
            t0 = 0; n0 = 132;
          } else {
            kind = 2;
            r0 = qt * 2;
            const int bs = clampi(r0 - 4, 0, 120);
            const int be = clampi(r0 + 1 - 4, 0, 120) + 8;
            Qp = QKV + Q_NA + (size_t)(b * 4 + h) * SS * 64; Kp = QKV + K_NA + (size_t)(b * 4 + h) * SS * 64;
            Vp = QKV + V_NA + (size_t)(b * 4 + h) * 64 * SS; Op = O + (size_t)(b * SS + q0) * 1024 + 0 + h * 64;
            t0 = 0; n0 = 4; t1 = 4 + bs; n1 = be - bs;
          }
        } else if (it < 3072 + 1056) {
          kind = 3;
          const int j = it - 3072;
          sg_ec = j >> 2; sg_g = j & 3;
          if (last && (sg_ec % 66) < 2) continue;
        } else {
          const int j = it - (3072 + 1056);
          const int typ = j >> 5, rem = j & 31;
          const int qt = rem & 1, h = (rem >> 1) & 3, b = rem >> 3;
          q0 = qt * 128;
          t0 = 0; n0 = 4;
          if (typ == 1) {
            kind = 0;
            Qp = QKV + Q_MLA + (size_t)(b * 4 + h) * SS * 96; Kp = QKV + K_MLA + (size_t)(b * 4 + h) * SS * 96;
            Vp = QKV + V_MLA + (size_t)(b * 4 + h) * 64 * SS; Op = O + (size_t)(b * SS + q0) * 1024 + 256 + h * 64;
          } else if (typ == 0) {
            kind = 1;
            mref1 = mref_na;
            Qp = QKV + Q_NA + (size_t)(b * 4 + h) * SS * 64; Kp = QKV + K_NA + (size_t)(b * 4 + h) * SS * 64;
            Vp = QKV + V_NA + (size_t)(b * 4 + h) * 64 * SS; Op = O + (size_t)(b * SS + q0) * 1024 + 0 + h * 64;
          } else {
            kind = 1;
            const int g = h >> 1;
            Qp = QKV + Q_GQA + (size_t)(b * 4 + h) * SS * 64; Kp = QKV + K_GQA + (size_t)(b * 2 + g) * SS * 64;
            Vp = QKV + V_GQA + (size_t)(b * 2 + g) * 64 * SS; Op = O + (size_t)(b * SS + q0) * 1024 + 768 + h * 64;
          }
        }
        if (kind == 0) {
#ifndef NO_A96
          attn_item<96, false>(Qp, Kp, Vp, q0, t0, n0, t1, n1, sc_mla, mref_mla, Op, 0, nullptr, ldsu, rpb_lds);
#endif
        } else if (kind == 1) {
#ifndef NO_A64
          attn_item<64, false>(Qp, Kp, Vp, q0, t0, n0, t1, n1, sc_64, mref1, Op, 0, nullptr, ldsu, rpb_lds);
#endif
        } else if (kind == 2) {
#ifndef NO_NA
          attn_item<64, true>(Qp, Kp, Vp, q0, t0, n0, t1, n1, sc_64, mref_na, Op, r0, rpb + hsel * 465, ldsu, rpb_lds);
#endif
        } else {
          const int ec = sg_ec, g = sg_g;
          f32x4 acc[4][2];
          gemm_core<64>([&](int r) { return (const u16*)(W + OW_SG + (size_t)(g * 128 + r) * 128); },
                        [&](int n) { return (const u16*)(QKV + SG_VT + (size_t)ec * 32768 + (size_t)(g * 64 + n) * 128); }, 2, acc, ldsu);
      const int tid = opaque_tid(), lane = tid & 63, w = tid >> 6, l15 = lane & 15, quad = lane >> 4, wm = w >> 1, wn = w & 1; (void)lane; (void)wm; (void)wn; (void)l15; (void)quad;
          asm volatile("" ::: "memory");
          const u16* ub = QKV + SG_U + (size_t)ec * 128 * 256 + g * 64;
          u16* ob = O + (size_t)ec * 128 * 1024 + 512 + g * 64;
          const float* sb = sgb + g * 128;
          float uu[4][2][4];
#pragma unroll
          for (int i = 0; i < 4; i++)
#pragma unroll
            for (int jj = 0; jj < 2; jj++)
#pragma unroll
              for (int e = 0; e < 4; e++) uu[i][jj][e] = bf2f(ub[ACC_ROW(i, e) * 256 + ACC_COL(64, jj)]);
#pragma unroll
          for (int i = 0; i < 4; i++)
#pragma unroll
            for (int e = 0; e < 4; e++) {
              const int pr = ACC_ROW(i, e);
              const float bb = sb[pr];
#pragma unroll
              for (int jj = 0; jj < 2; jj++) ob[pr * 1024 + ACC_COL(64, jj)] = f2bf(uu[i][jj][e] * (acc[i][jj][e] + bb));
            }
        }
      }
    }

    }
    }
#endif
    xcd_barrier(xbar);

#ifndef SKIP_P7
    {
    for (int rep_ = 0; rep_ < REP_P7; rep_++) {
    const int tid = opaque_tid(), lane = tid & 63, w = tid >> 6, l15 = lane & 15, quad = lane >> 4;
    const int wm = w >> 1, wn = w & 1;
    (void)wm; (void)wn; (void)l15; (void)quad;
    {
      const float* bg = p.in[23] + (size_t)l * 4096;
      for (int it = vb; it < (last ? 256 : 264) * 16; it += G) {
        const int mi = it >> 4, nt = it & 15;
        const int mt = last ? ((mi >> 6) * 66 + 2 + (mi & 63)) : mi;
        const int m0 = mt * 128, n0 = nt * 64;
        f32x4 y[4][2];
#pragma unroll
        for (int i = 0; i < 4; i++)
#pragma unroll
          for (int j = 0; j < 2; j++) y[i][j] = f32x4{0.f, 0.f, 0.f, 0.f};
        for (int br = 0; br < 4; br++) {
          f32x4 ag[4][2], ap2[4][2];
          gemm_dual<64>([&](int r) { return (const u16*)(H + (size_t)(m0 + r) * DD); },
                        [&](int n) { return (const u16*)(W + OW_GATE + (size_t)br * 1048576 + (size_t)(n0 + n) * 1024); }, 16, ag,
                        [&](int r) { return (const u16*)(O + (size_t)(m0 + r) * 1024 + br * 256); },
                        [&](int n) { return (const u16*)(W + OW_BRANCH + (size_t)br * 262144 + (size_t)(n0 + n) * 256); }, 4, ap2, ldsu);
      const int tid = opaque_tid(), lane = tid & 63, w = tid >> 6, l15 = lane & 15, quad = lane >> 4, wm = w >> 1, wn = w & 1; (void)lane; (void)wm; (void)wn; (void)l15; (void)quad;
#pragma unroll
          for (int j = 0; j < 2; j++) {
            const float bv = bg[br * 1024 + n0 + ACC_COL(64, j)];
#pragma unroll
            for (int i = 0; i < 4; i++)
#pragma unroll
              for (int e = 0; e < 4; e++) y[i][j][e] += sigmoid_f(ag[i][j][e] + bv) * ap2[i][j][e];
          }
        }
#pragma unroll
        for (int i = 0; i < 4; i++)
#pragma unroll
          for (int j = 0; j < 2; j++)
#pragma unroll
            for (int e = 0; e < 4; e++) Y[(size_t)(m0 + ACC_ROW(i, e)) * 1024 + n0 + ACC_COL(64, j)] = f2bf(y[i][j][e]);
      }
    }
    }
    }
#endif
    xcd_barrier(xbar);

#ifndef SKIP_P8
    {
    {
    const int tid = opaque_tid(), lane = tid & 63, w = tid >> 6, l15 = lane & 15, quad = lane >> 4;
    const int wm = w >> 1, wn = w & 1;
    (void)wm; (void)wn; (void)l15; (void)quad;
    {
    const int nwide = 256 * 4;
    const int total_items = nwide + (last ? 0 : 64);
    for (int it = vb; it < total_items; it += G) {
      if (it < nwide) {
        const int mi = it >> 2, nt = it & 3;
        const int mt = (mi >> 6) * 66 + 2 + (mi & 63);
        const int m0 = mt * 128, n0 = nt * 256;
        const int b = m0 / SS;
        f32x4 acc[4][8];
        gemm_wide([&](int r) { return (const u16*)(Y + (size_t)(m0 + r) * 1024); },
                  [&](int n) { return (const u16*)(W + OW_OUT + (size_t)(n0 + n) * 1024); }, 32, acc, ldsu);
        const int tid = opaque_tid(), lane = tid & 63, w = tid >> 6, l15 = lane & 15, quad = lane >> 4, wm = w >> 1, wn = w & 1; (void)lane; (void)wm; (void)wn; (void)l15; (void)quad;
        const float* g1 = modl + (size_t)b * 6144 + 2 * 1024;
        const float* xi = xrow(xin, m0) + n0;
        float* xo = xrow(xout, m0) + n0;
        asm volatile("" ::: "memory");
#pragma unroll
        for (int jh = 0; jh < 4; jh++) {
          float xv[2][4][4];
#pragma unroll
          for (int j = 0; j < 2; j++)
#pragma unroll
            for (int i = 0; i < 4; i++)
#pragma unroll
              for (int e = 0; e < 4; e++) xv[j][i][e] = xi[ACC_ROW(i, e) * 1024 + ACC_COLW(jh * 2 + j)];
#pragma unroll
          for (int j = 0; j < 2; j++) {
            const float gv = g1[n0 + ACC_COLW(jh * 2 + j)];
#pragma unroll
            for (int i = 0; i < 4; i++)
#pragma unroll
              for (int e = 0; e < 4; e++) xo[ACC_ROW(i, e) * 1024 + ACC_COLW(jh * 2 + j)] = xv[j][i][e] + gv * acc[i][jh * 2 + j][e];
          }
        }
        continue;
      }
      const int jc = it - nwide;
      const int mc = jc >> 3, nt = jc & 7;
      const int mt = (mc >> 1) * 66 + (mc & 1);
      const int m0 = mt * 128, n0 = nt * 128;
      const int b = m0 / SS, s0 = m0 - b * SS;
      const int mrow = (s0 < CC) ? 4 : b;
      f32x4 acc[4][4];
      gemm_core<128>([&](int r) { return (const u16*)(Y + (size_t)(m0 + r) * 1024); },
                     [&](int n) { return (const u16*)(W + OW_OUT + (size_t)(n0 + n) * 1024); }, 16, acc, ldsu);
      const int tid = opaque_tid(), lane = tid & 63, w = tid >> 6, l15 = lane & 15, quad = lane >> 4, wm = w >> 1, wn = w & 1; (void)lane; (void)wm; (void)wn; (void)l15; (void)quad;
      const float* g1 = modl + (size_t)mrow * 6144 + 2 * 1024;
      const float* xi = xrow(xin, m0) + n0;
      float* xo = xrow(xout, m0) + n0;
      asm volatile("" ::: "memory");
#pragma unroll
      for (int jh = 0; jh < 2; jh++) {
        float xv[2][4][4];
#pragma unroll
        for (int j = 0; j < 2; j++)
#pragma unroll
          for (int i = 0; i < 4; i++)
#pragma unroll
            for (int e = 0; e < 4; e++) xv[j][i][e] = xi[ACC_ROW(i, e) * 1024 + ACC_COL(128, jh * 2 + j)];
#pragma unroll
        for (int j = 0; j < 2; j++) {
          const float gv = g1[n0 + ACC_COL(128, jh * 2 + j)];
#pragma unroll
          for (int i = 0; i < 4; i++)
#pragma unroll
            for (int e = 0; e < 4; e++) xo[ACC_ROW(i, e) * 1024 + ACC_COL(128, jh * 2 + j)] = xv[j][i][e] + gv * acc[i][jh * 2 + j][e];
        }
      }
    }
    }
    }
    }
#endif
    xcd_barrier(xbar);

#ifndef SKIP_P9
    for (int rep_ = 0; rep_ < REP_P9; rep_++) {
    phase_modulate(xout, modl, 3, 4, H, last, vb, G);
    }
#endif
    xcd_barrier(xbar);

#ifndef SKIP_P10
    {
    for (int rep_ = 0; rep_ < REP_P10; rep_++) {
    const int tid = opaque_tid(), lane = tid & 63, w = tid >> 6, l15 = lane & 15, quad = lane >> 4;
    const int wm = w >> 1, wn = w & 1;
    (void)wm; (void)wn; (void)l15; (void)quad;
    {
      const float* cw = p.in[26] + (size_t)l * 3 * 5632;
      const float* cb = p.in[27] + (size_t)l * 5632;
      const int tpb = last ? 66 : 69;
      const int total = NB * tpb * 22;
      for (int it = vb; it < total; it += G) {
        const int MT = NB * tpb;
        const int g8 = it / (8 * 22);
        const int rem = it - g8 * (8 * 22);
        const int gsz = (MT - g8 * 8) < 8 ? (MT - g8 * 8) : 8;
        const int nt = rem / gsz;
        const int mt = g8 * 8 + (rem - nt * gsz);
        const int b = mt / tpb;
        int ti = mt - b * tpb;
        int seg_lo, seg_hi;
        if (last) { seg_lo = CC; seg_hi = SS; }
        else if (ti < 3) { seg_lo = 0; seg_hi = CC; }
        else { ti -= 3; seg_lo = CC; seg_hi = SS; }
        const int sfirst = seg_lo + 126 * ti - 1;
        const int c0 = nt * 128;
        f32x4 acc[4][8];
        gemm_wide([&](int r) { int s = sfirst + r; return (s >= seg_lo && s < seg_hi) ? (const u16*)(H + (size_t)(b * SS + s) * DD) : (const u16*)(p.ws + WS_ZROW); },
                  [&](int n) { int ch = ((n >> 7) ? FF : 0) + c0 + (n & 127); return (const u16*)(W + OW_UP + (size_t)ch * 1024); }, 32, acc, ldsu);
      const int tid = opaque_tid(), lane = tid & 63, w = tid >> 6, l15 = lane & 15, quad = lane >> 4, wm = w >> 1, wn = w & 1; (void)lane; (void)wm; (void)wn; (void)l15; (void)quad;
#pragma unroll
        for (int pss = 0; pss < 2; pss++) {
        if (pss) __syncthreads();
#pragma unroll
        for (int i = 0; i < 4; i++)
#pragma unroll
          for (int j = 0; j < 4; j++)
            *(f32x4*)(ldsf + ACC_COL(128, j) * 132 + wm * 64 + i * 16 + quad * 4) = acc[i][pss * 4 + j];
        __syncthreads();
        const int cc = tid & 63, rg = tid >> 6;
        const int ch = c0 + pss * 64 + cc;
        const float wa0 = cw[ch], wa1 = cw[5632 + ch], wa2 = cw[2 * 5632 + ch], ba = cb[ch];
        const float wg0 = cw[FF + ch], wg1 = cw[5632 + FF + ch], wg2 = cw[2 * 5632 + FF + ch], bgv = cb[FF + ch];
        u16* actb = ACT + (size_t)(b * SS) * FF + ch;
        const float* sa = ldsf + cc * 132;
        const float* sg = ldsf + (64 + cc) * 132;
#pragma unroll 4
        for (int i = 0; i < 8; i++) {
          const int r0 = (rg + 4 * i) * 4;
          const f32x4 a4 = *(const f32x4*)(sa + r0);
          const f32x4 g4 = *(const f32x4*)(sg + r0);
          const float am = (r0 > 0) ? sa[r0 - 1] : 0.f, ap = sa[r0 + 4];
          const float gm = (r0 > 0) ? sg[r0 - 1] : 0.f, gp = sg[r0 + 4];
          float av[4], gv[4];
          av[0] = wa0 * am + wa1 * a4[0] + wa2 * a4[1] + ba;
          av[1] = wa0 * a4[0] + wa1 * a4[1] + wa2 * a4[2] + ba;
          av[2] = wa0 * a4[1] + wa1 * a4[2] + wa2 * a4[3] + ba;
          av[3] = wa0 * a4[2] + wa1 * a4[3] + wa2 * ap + ba;
          gv[0] = wg0 * gm + wg1 * g4[0] + wg2 * g4[1] + bgv;
          gv[1] = wg0 * g4[0] + wg1 * g4[1] + wg2 * g4[2] + bgv;
          gv[2] = wg0 * g4[1] + wg1 * g4[2] + wg2 * g4[3] + bgv;
          gv[3] = wg0 * g4[2] + wg1 * g4[3] + wg2 * gp + bgv;
#pragma unroll
          for (int e = 0; e < 4; e++) {
            const int r = r0 + e;
            const int s = sfirst + r;
            if (r >= 1 && r <= 126 && s >= seg_lo && s < seg_hi) actb[(size_t)s * FF] = f2bf(silu_f(gv[e]) * av[e]);
          }
        }
        }
      }
    }
    }
    }
#endif
    xcd_barrier(xbar);

#ifndef SKIP_P11
    {
    {
    const int tid = opaque_tid(), lane = tid & 63, w = tid >> 6, l15 = lane & 15, quad = lane >> 4;
    const int wm = w >> 1, wn = w & 1;
    (void)wm; (void)wn; (void)l15; (void)quad;
    {
    const int nwide = 256 * 4;
    const int total_items = nwide + (last ? 0 : 64);
    for (int it = vb; it < total_items; it += G) {
      if (it < nwide) {
        const int mi = it >> 2, nt = it & 3;
        const int mt = (mi >> 6) * 66 + 2 + (mi & 63);
        const int m0 = mt * 128, n0 = nt * 256;
        const int b = m0 / SS;
        f32x4 acc[4][8];
        gemm_wide([&](int r) { return (const u16*)(ACT + (size_t)(m0 + r) * FF); },
                  [&](int n) { return (const u16*)(W + OW_DOWN + (size_t)(n0 + n) * FF); }, 88, acc, ldsu);
        const int tid = opaque_tid(), lane = tid & 63, w = tid >> 6, l15 = lane & 15, quad = lane >> 4, wm = w >> 1, wn = w & 1; (void)lane; (void)wm; (void)wn; (void)l15; (void)quad;
        const float* g2 = modl + (size_t)b * 6144 + 5 * 1024;

        float* xo = xrow(xout, m0) + n0;
        asm volatile("" ::: "memory");
#pragma unroll
        for (int jh = 0; jh < 4; jh++) {
          float xv[2][4][4];
#pragma unroll
          for (int j = 0; j < 2; j++)
#pragma unroll
            for (int i = 0; i < 4; i++)
#pragma unroll
              for (int e = 0; e < 4; e++) xv[j][i][e] = xo[ACC_ROW(i, e) * 1024 + ACC_COLW(jh * 2 + j)];
#pragma unroll
          for (int j = 0; j < 2; j++) {
            const float gv = g2[n0 + ACC_COLW(jh * 2 + j)];
#pragma unroll
            for (int i = 0; i < 4; i++)
#pragma unroll
              for (int e = 0; e < 4; e++) xo[ACC_ROW(i, e) * 1024 + ACC_COLW(jh * 2 + j)] = xv[j][i][e] + gv * acc[i][jh * 2 + j][e];
          }
        }
        continue;
      }
      const int jc = it - nwide;
      const int mc = jc >> 3, nt = jc & 7;
      const int mt = (mc >> 1) * 66 + (mc & 1);
      const int m0 = mt * 128, n0 = nt * 128;
      const int b = m0 / SS, s0 = m0 - b * SS;
      const int mrow = (s0 < CC) ? 4 : b;
      f32x4 acc[4][4];
      gemm_core<128>([&](int r) { return (const u16*)(ACT + (size_t)(m0 + r) * FF); },
                     [&](int n) { return (const u16*)(W + OW_DOWN + (size_t)(n0 + n) * FF); }, 44, acc, ldsu);
      const int tid = opaque_tid(), lane = tid & 63, w = tid >> 6, l15 = lane & 15, quad = lane >> 4, wm = w >> 1, wn = w & 1; (void)lane; (void)wm; (void)wn; (void)l15; (void)quad;
      const float* g2 = modl + (size_t)mrow * 6144 + 5 * 1024;
      float* xo = xrow(xout, m0) + n0;
      asm volatile("" ::: "memory");
#pragma unroll
      for (int jh = 0; jh < 2; jh++) {
        float xv[2][4][4];
#pragma unroll
        for (int j = 0; j < 2; j++)
#pragma unroll
          for (int i = 0; i < 4; i++)
#pragma unroll
            for (int e = 0; e < 4; e++) xv[j][i][e] = xo[ACC_ROW(i, e) * 1024 + ACC_COL(128, jh * 2 + j)];
#pragma unroll
        for (int j = 0; j < 2; j++) {
          const float gv = g2[n0 + ACC_COL(128, jh * 2 + j)];
#pragma unroll
          for (int i = 0; i < 4; i++)
#pragma unroll
            for (int e = 0; e < 4; e++) xo[ACC_ROW(i, e) * 1024 + ACC_COL(128, jh * 2 + j)] = xv[j][i][e] + gv * acc[i][jh * 2 + j][e];
        }
      }
    }
    }
    }
    }
#endif
  }
}

extern "C" void kernel_launch(void* const* d_in, const int* in_sizes, int n_in, void* d_out, int out_size,
                              void* d_ws, size_t ws_size, hipStream_t stream) {
  static int grid_blocks = 0;
  if (!grid_blocks) {
    int dev = 0, cus = 0, per_cu = 0;
    (void)hipGetDevice(&dev);
    (void)hipDeviceGetAttribute(&cus, hipDeviceAttributeMultiprocessorCount, dev);
    (void)hipOccupancyMaxActiveBlocksPerMultiprocessor(&per_cu, fwd_megakernel, 256, 0);
    if (per_cu > 2) per_cu = 2;
    if (per_cu < 1) per_cu = 1;
    grid_blocks = cus * per_cu;
    if (ws_size < WS_END) fprintf(stderr, "workspace too small: %zu < %zu\n", ws_size, (size_t)WS_END);
  }
  Params p{};
  for (int i = 0; i < 29; i++) p.in[i] = (const float*)d_in[i];
  p.out = (float*)d_out;
  p.ws = (char*)d_ws;
  p.pad = 0;
  (void)hipMemsetAsync((char*)d_ws + WS_BAR, 0, 3456 * 4, stream);
  void* args[] = {&p};
  hipError_t e = hipLaunchCooperativeKernel((void*)fwd_megakernel, dim3(grid_blocks), dim3(256), args, 0, stream);
  if (e != hipSuccess) fprintf(stderr, "cooperative launch failed: %s (grid %d)\n", hipGetErrorString(e), grid_blocks);
}
```

```cpp
#include <hip/hip_runtime.h>
#include <hip/hip_bf16.h>
#include <hip/hip_cooperative_groups.h>
#include <cstdio>
#include <cstdint>
namespace cg = cooperative_groups;

typedef unsigned short u16;
using bf16x8 = __attribute__((ext_vector_type(8))) short;
using f32x4 = __attribute__((ext_vector_type(4))) float;
using u32x4 = __attribute__((ext_vector_type(4))) unsigned;

#define DEV __device__ __forceinline__
#ifndef REP_P0
#define REP_P0 1
#endif
#ifndef REP_SYNC
#define REP_SYNC 0
#endif
#ifndef REP_P3
#define REP_P3 1
#endif
#ifndef REP_P8
#define REP_P8 1
#endif
#ifndef REP_P11
#define REP_P11 1
#endif
#ifndef REP_P1
#define REP_P1 1
#endif
#ifndef REP_P2
#define REP_P2 1
#endif
#ifndef REP_P4
#define REP_P4 1
#endif
#ifndef REP_P6
#define REP_P6 1
#endif
#ifndef REP_P7
#define REP_P7 1
#endif
#ifndef REP_P9
#define REP_P9 1
#endif
#ifndef REP_P10
#define REP_P10 1
#endif

constexpr int NB = 4, TT = 8192, CC = 256, SS = 8448, MM = NB * SS, DD = 1024;
constexpr int ZW = 2304, FF = 2816;
constexpr float EPS = 1e-6f;
constexpr float LOG2E = 1.4426950408889634f;

constexpr size_t OW_IN = 0;
constexpr size_t OW_GATE = OW_IN + (size_t)2304 * 1024;
constexpr size_t OW_BRANCH = OW_GATE + (size_t)4 * 1024 * 1024;
constexpr size_t OW_OUT = OW_BRANCH + (size_t)4 * 1024 * 256;
constexpr size_t OW_UP = OW_OUT + (size_t)1024 * 1024;
constexpr size_t OW_DOWN = OW_UP + (size_t)5632 * 1024;
constexpr size_t OW_UQ = OW_DOWN + (size_t)1024 * 2816;
constexpr size_t OW_UKV = OW_UQ + (size_t)384 * 256;
constexpr size_t OW_SG = OW_UKV + (size_t)512 * 192;
constexpr size_t WL = OW_SG + (size_t)4 * 128 * 128;

constexpr size_t WS_W = 0;
constexpr size_t WS_MOD = WS_W + 2 * WL * 2;
constexpr size_t WS_R16 = WS_MOD + (size_t)2 * 5 * 6144 * 4;
constexpr size_t WS_R8 = WS_R16 + (size_t)128 * 16 * 8;
constexpr size_t WS_CX = WS_R8 + (size_t)128 * 8 * 8;
constexpr size_t WS_H = WS_CX + (size_t)NB * CC * DD * 4;
constexpr size_t WS_Z = WS_H + (size_t)MM * DD * 2;
constexpr size_t WS_QKV = WS_Z + (size_t)MM * ZW * 2;
constexpr size_t WS_ZROW = WS_QKV + (size_t)MM * FF * 2;
constexpr size_t WS_BAR = WS_ZROW + 4096;
constexpr size_t WS_END = WS_BAR + 3456 * 4;

constexpr size_t Q_NA = 0;
constexpr size_t K_NA = (size_t)MM * 256;
constexpr size_t V_NA = (size_t)MM * 512;
constexpr size_t Q_MLA = (size_t)MM * 768;
constexpr size_t K_MLA = (size_t)MM * 1152;
constexpr size_t V_MLA = (size_t)MM * 1536;
constexpr size_t Q_GQA = (size_t)MM * 1792;
constexpr size_t K_GQA = (size_t)MM * 2048;
constexpr size_t V_GQA = (size_t)MM * 2176;
constexpr size_t SG_U = (size_t)MM * 2304;
constexpr size_t SG_VT = (size_t)MM * 2560;

constexpr int SMEM_BYTES = 67584;

struct Params {
  const float* in[29];
  float* out;
  char* ws;
  long pad;
};

DEV float bf2f(u16 h) { return __uint_as_float(((unsigned)h) << 16); }
DEV u16 f2bf(float f) {
  __bf16 r = (__bf16)f;
  return __builtin_bit_cast(u16, r);
}
typedef __bf16 bf16x2_t __attribute__((ext_vector_type(2)));
typedef float f32x2_t __attribute__((ext_vector_type(2)));
DEV unsigned pack2(float a, float b) {
  f32x2_t v = {a, b};
  bf16x2_t r = __builtin_convertvector(v, bf16x2_t);
  return __builtin_bit_cast(unsigned, r);
}
DEV void load8(const u16* p, float (&f)[8]) {
  uint4 v = *(const uint4*)p;
  f[0] = __uint_as_float(v.x << 16); f[1] = __uint_as_float(v.x & 0xffff0000u);
  f[2] = __uint_as_float(v.y << 16); f[3] = __uint_as_float(v.y & 0xffff0000u);
  f[4] = __uint_as_float(v.z << 16); f[5] = __uint_as_float(v.z & 0xffff0000u);
  f[6] = __uint_as_float(v.w << 16); f[7] = __uint_as_float(v.w & 0xffff0000u);
}
DEV void store8(u16* p, const float (&f)[8]) {
  uint4 v;
  v.x = pack2(f[0], f[1]); v.y = pack2(f[2], f[3]); v.z = pack2(f[4], f[5]); v.w = pack2(f[6], f[7]);
  *(uint4*)p = v;
}
DEV float silu_f(float x) { return x * __builtin_amdgcn_rcpf(1.f + __expf(-x)); }
DEV float sigmoid_f(float x) { return __builtin_amdgcn_rcpf(1.f + __expf(-x)); }
DEV float gelu_f(float x) {
  float y = 0.7978845608028654f * (x + 0.044715f * x * x * x);
  float t = 1.f - 2.f * __builtin_amdgcn_rcpf(__expf(2.f * y) + 1.f);
  return 0.5f * x * (1.f + t);
}
DEV int perm32(int s) {
  int k = s & 31;
  int pos = ((k >> 2) & 3) * 8 + (k >> 4) * 4 + (k & 3);
  return (s & ~31) | pos;
}
DEV int opaque_tid() { int t = threadIdx.x; asm volatile("" : "+v"(t)); return t; }
DEV float shfl_xor_f(float v, int mask) {
  int ln = __builtin_amdgcn_mbcnt_hi(~0u, __builtin_amdgcn_mbcnt_lo(~0u, 0u));
  asm volatile("" : "+v"(ln));
  return __int_as_float(__builtin_amdgcn_ds_bpermute((ln ^ mask) << 2, __float_as_int(v)));
}
DEV int clampi(int v, int lo, int hi) { return v < lo ? lo : (v > hi ? hi : v); }

struct XMap { float* lat; float* ctx; };
DEV float* xrow(const XMap& xm, int m) {
  int b = m / SS;
  int s = m - b * SS;
  return s < CC ? xm.ctx + ((size_t)(b * CC + s)) * DD : xm.lat + ((size_t)(b * TT + s - CC)) * DD;
}

template <int BN, class AF, class BF>
DEV void gemm_core(AF arow, BF brow, int nk, f32x4 (&acc)[4][BN / 32], u16* lds) {
  constexpr int NF = BN / 32;
  constexpr int STAGE = (128 + BN) * 64;
  constexpr int NBI = (BN * 8) / 256;
  static_assert((BN * 8) % 256 == 0, "BN");
  const int tid = opaque_tid(), lane = tid & 63, w = tid >> 6, l15 = lane & 15, quad = lane >> 4;
  const int wm = w >> 1, wn = w & 1;
  const u16* ap[4];
  const u16* bp[NBI];
#pragma unroll
  for (int i = 0; i < 4; i++) {
    int c = tid + i * 256;
    ap[i] = arow(c >> 3) + (c & 7) * 8;
  }
#pragma unroll
  for (int i = 0; i < NBI; i++) {
    int c = tid + i * 256;
    bp[i] = brow(c >> 3) + (c & 7) * 8;
  }
  const int srow = tid >> 3;
  const int soff = srow * 64 + (((tid & 7) ^ ((srow >> 1) & 7)) * 8);
  const int swz = (l15 >> 1) & 7;
  u32x4 r0a[4], r0b[NBI], r1a[4], r1b[NBI];
#pragma unroll
  for (int i = 0; i < 4; i++)
#pragma unroll
    for (int j = 0; j < NF; j++) acc[i][j] = f32x4{0.f, 0.f, 0.f, 0.f};

#define GLOAD(RA, RB, KT)                                                              \
  {                                                                                    \
    _Pragma("unroll") for (int i = 0; i < 4; i++) RA[i] = *(const u32x4*)(ap[i] + (KT) * 64);   \
    _Pragma("unroll") for (int i = 0; i < NBI; i++) RB[i] = *(const u32x4*)(bp[i] + (KT) * 64); \
  }
#define SSTORE(RA, RB, ST)                                                             \
  {                                                                                    \
    u16* A_ = lds + (ST) * STAGE;                                                      \
    u16* B_ = A_ + 128 * 64;                                                           \
    _Pragma("unroll") for (int i = 0; i < 4; i++) *(u32x4*)(A_ + soff + i * 32 * 64) = RA[i];   \
    _Pragma("unroll") for (int i = 0; i < NBI; i++) *(u32x4*)(B_ + soff + i * 32 * 64) = RB[i]; \
  }
#define LFRAGS(ST)                                                                     \
    const u16* A_ = lds + (ST) * STAGE;                                                \
    const u16* B_ = A_ + 128 * 64;                                                     \
    bf16x8 af[2][4], bfr[2][NF];                                                       \
    _Pragma("unroll") for (int ks = 0; ks < 2; ks++) {                                 \
      const int co = (((ks * 4 + quad) ^ swz) * 8);                                    \
      _Pragma("unroll") for (int i = 0; i < 4; i++) af[ks][i] = *(const bf16x8*)(A_ + (wm * 64 + i * 16 + l15) * 64 + co);          \
      _Pragma("unroll") for (int j = 0; j < NF; j++) bfr[ks][j] = *(const bf16x8*)(B_ + (wn * (BN / 2) + j * 16 + l15) * 64 + co);  \
    }
#define MFMAS(KS)                                                                      \
    _Pragma("unroll") for (int i = 0; i < 4; i++)                                      \
      _Pragma("unroll") for (int j = 0; j < NF; j++)                                   \
        acc[i][j] = __builtin_amdgcn_mfma_f32_16x16x32_bf16(af[KS][i], bfr[KS][j], acc[i][j], 0, 0, 0);

  __syncthreads();
  GLOAD(r0a, r0b, 0);
  if (nk > 1) GLOAD(r1a, r1b, 1);
  SSTORE(r0a, r0b, 0);
  __syncthreads();
  for (int kt = 0; kt < nk; kt += 2) {
    {
      if (kt + 2 < nk) GLOAD(r0a, r0b, kt + 2);
      LFRAGS(0);
      __builtin_amdgcn_sched_barrier(0);
      MFMAS(0);
      __builtin_amdgcn_sched_barrier(0);
      if (kt + 1 < nk) SSTORE(r1a, r1b, 1);
      __builtin_amdgcn_sched_barrier(0);
      MFMAS(1);
      __syncthreads();
    }
    if (kt + 1 >= nk) break;
    {
      if (kt + 3 < nk) GLOAD(r1a, r1b, kt + 3);
      LFRAGS(1);
      __builtin_amdgcn_sched_barrier(0);
      MFMAS(0);
      __builtin_amdgcn_sched_barrier(0);
      if (kt + 2 < nk) SSTORE(r0a, r0b, 0);
      __builtin_amdgcn_sched_barrier(0);
      MFMAS(1);
      __syncthreads();
    }
  }
#undef GLOAD
#undef SSTORE
#undef LFRAGS
#undef MFMAS
}

template <int BN, class AF1, class BF1, class AF2, class BF2>
DEV void gemm_dual(AF1 arow1, BF1 brow1, int nk1, f32x4 (&acc1)[4][BN / 32], AF2 arow2, BF2 brow2, int nk2,
                   f32x4 (&acc2)[4][BN / 32], u16* lds) {
  constexpr int NF = BN / 32;
  constexpr int STAGE = (128 + BN) * 64;
  constexpr int NBI = (BN * 8) / 256;
  const int tid = opaque_tid(), lane = tid & 63, w = tid >> 6, l15 = lane & 15, quad = lane >> 4;
  const int wm = w >> 1, wn = w & 1;
  const int nk = nk1 + nk2;
  const u16* ap1[4]; const u16* bp1[NBI]; const u16* ap2[4]; const u16* bp2[NBI];
#pragma unroll
  for (int i = 0; i < 4; i++) {
    int c = tid + i * 256;
    ap1[i] = arow1(c >> 3) + (c & 7) * 8;
    ap2[i] = arow2(c >> 3) + (c & 7) * 8 - (size_t)nk1 * 64;
  }
#pragma unroll
  for (int i = 0; i < NBI; i++) {
    int c = tid + i * 256;
    bp1[i] = brow1(c >> 3) + (c & 7) * 8;
    bp2[i] = brow2(c >> 3) + (c & 7) * 8 - (size_t)nk1 * 64;
  }
  const int srow = tid >> 3;
  const int soff = srow * 64 + (((tid & 7) ^ ((srow >> 1) & 7)) * 8);
  const int swz = (l15 >> 1) & 7;
  u32x4 r0a[4], r0b[NBI], r1a[4], r1b[NBI];
#pragma unroll
  for (int i = 0; i < 4; i++)
#pragma unroll
    for (int j = 0; j < NF; j++) { acc1[i][j] = f32x4{0.f, 0.f, 0.f, 0.f}; acc2[i][j] = f32x4{0.f, 0.f, 0.f, 0.f}; }

#define GLOAD(RA, RB, KT)                                                              \
  {                                                                                    \
    const bool s2_ = (KT) >= nk1;                                                      \
    _Pragma("unroll") for (int i = 0; i < 4; i++) RA[i] = *(const u32x4*)((s2_ ? ap2[i] : ap1[i]) + (KT) * 64);   \
    _Pragma("unroll") for (int i = 0; i < NBI; i++) RB[i] = *(const u32x4*)((s2_ ? bp2[i] : bp1[i]) + (KT) * 64); \
  }
#define SSTORE(RA, RB, ST)                                                             \
  {                                                                                    \
    u16* A_ = lds + (ST) * STAGE;                                                      \
    u16* B_ = A_ + 128 * 64;                                                           \
    _Pragma("unroll") for (int i = 0; i < 4; i++) *(u32x4*)(A_ + soff + i * 32 * 64) = RA[i];   \
    _Pragma("unroll") for (int i = 0; i < NBI; i++) *(u32x4*)(B_ + soff + i * 32 * 64) = RB[i]; \
  }
#define LFRAGS(ST)                                                                     \
    const u16* A_ = lds + (ST) * STAGE;                                                \
    const u16* B_ = A_ + 128 * 64;                                                     \
    bf16x8 af[2][4], bfr[2][NF];                                                       \
    _Pragma("unroll") for (int ks = 0; ks < 2; ks++) {                                 \
      const int co = (((ks * 4 + quad) ^ swz) * 8);                                    \
      _Pragma("unroll") for (int i = 0; i < 4; i++) af[ks][i] = *(const bf16x8*)(A_ + (wm * 64 + i * 16 + l15) * 64 + co);          \
      _Pragma("unroll") for (int j = 0; j < NF; j++) bfr[ks][j] = *(const bf16x8*)(B_ + (wn * (BN / 2) + j * 16 + l15) * 64 + co);  \
    }
#define MFMAS(ACC, KS)                                                                 \
    _Pragma("unroll") for (int i = 0; i < 4; i++)                                      \
      _Pragma("unroll") for (int j = 0; j < NF; j++)                                   \
        ACC[i][j] = __builtin_amdgcn_mfma_f32_16x16x32_bf16(af[KS][i], bfr[KS][j], ACC[i][j], 0, 0, 0);
#define STEP_PAIR(ACC)                                                                 \
    {                                                                                  \
      if (kt + 2 < nk) GLOAD(r0a, r0b, kt + 2);                                        \
      LFRAGS(0);                                                                       \
      __builtin_amdgcn_sched_barrier(0);                                               \
      MFMAS(ACC, 0);                                                                   \
      __builtin_amdgcn_sched_barrier(0);                                               \
      SSTORE(r1a, r1b, 1);                                                             \
      __builtin_amdgcn_sched_barrier(0);                                               \
      MFMAS(ACC, 1);                                                                   \
      __syncthreads();                                                                 \
    }                                                                                  \
    {                                                                                  \
      if (kt + 3 < nk) GLOAD(r1a, r1b, kt + 3);                                        \
      LFRAGS(1);                                                                       \
      __builtin_amdgcn_sched_barrier(0);                                               \
      MFMAS(ACC, 0);                                                                   \
      __builtin_amdgcn_sched_barrier(0);                                               \
      if (kt + 2 < nk) SSTORE(r0a, r0b, 0);                                            \
      __builtin_amdgcn_sched_barrier(0);                                               \
      MFMAS(ACC, 1);                                                                   \
      __syncthreads();                                                                 \
    }

  __syncthreads();
  GLOAD(r0a, r0b, 0);
  GLOAD(r1a, r1b, 1);
  SSTORE(r0a, r0b, 0);
  __syncthreads();
  for (int kt = 0; kt < nk1; kt += 2) { STEP_PAIR(acc1) }
  for (int kt = nk1; kt < nk; kt += 2) { STEP_PAIR(acc2) }
#undef GLOAD
#undef SSTORE
#undef LFRAGS
#undef MFMAS
#undef STEP_PAIR
}

template <class AF, class BF>
DEV void gemm_wide(AF arow, BF brow, int nk, f32x4 (&acc)[4][8], u16* lds) {
  constexpr int STAGE = (128 + 256) * 32;
  const int tid = opaque_tid(), lane = tid & 63, w = tid >> 6, l15 = lane & 15, quad = lane >> 4;
  const int wm = w >> 1, wn = w & 1;
  const u16* ap[2];
  const u16* bp[4];
#pragma unroll
  for (int i = 0; i < 2; i++) {
    int c = tid + i * 256;
    ap[i] = arow(c >> 2) + (c & 3) * 8;
  }
#pragma unroll
  for (int i = 0; i < 4; i++) {
    int c = tid + i * 256;
    bp[i] = brow(c >> 2) + (c & 3) * 8;
  }
  u32x4 ra[2], rb[4];
#pragma unroll
  for (int i = 0; i < 4; i++)
#pragma unroll
    for (int j = 0; j < 8; j++) acc[i][j] = f32x4{0.f, 0.f, 0.f, 0.f};
  __syncthreads();
#pragma unroll
  for (int i = 0; i < 2; i++) ra[i] = *(const u32x4*)(ap[i]);
#pragma unroll
  for (int i = 0; i < 4; i++) rb[i] = *(const u32x4*)(bp[i]);
  {
    u16* A_ = lds;
    u16* B_ = A_ + 128 * 32;
#pragma unroll
    for (int i = 0; i < 2; i++) *(u32x4*)(A_ + (tid + i * 256) * 8) = ra[i];
#pragma unroll
    for (int i = 0; i < 4; i++) *(u32x4*)(B_ + (tid + i * 256) * 8) = rb[i];
  }
  __syncthreads();
  for (int kt = 0; kt < nk; kt++) {
    const bool more = (kt + 1 < nk);
    if (more) {
#pragma unroll
      for (int i = 0; i < 2; i++) ra[i] = *(const u32x4*)(ap[i] + (kt + 1) * 32);
#pragma unroll
      for (int i = 0; i < 4; i++) rb[i] = *(const u32x4*)(bp[i] + (kt + 1) * 32);
    }
    const u16* A_ = lds + (kt & 1) * STAGE;
    const u16* B_ = A_ + 128 * 32;
    bf16x8 af[4], bfr[8];
#pragma unroll
    for (int i = 0; i < 4; i++) af[i] = *(const bf16x8*)(A_ + (wm * 64 + i * 16 + l15) * 32 + quad * 8);
#pragma unroll
    for (int j = 0; j < 8; j++) bfr[j] = *(const bf16x8*)(B_ + (wn * 128 + j * 16 + l15) * 32 + quad * 8);
    __builtin_amdgcn_sched_barrier(0);
    __builtin_amdgcn_s_setprio(1);
#pragma unroll
    for (int j = 0; j < 4; j++)
#pragma unroll
      for (int i = 0; i < 4; i++) acc[i][j] = __builtin_amdgcn_mfma_f32_16x16x32_bf16(af[i], bfr[j], acc[i][j], 0, 0, 0);
    __builtin_amdgcn_sched_barrier(0);
    if (more) {
      u16* A2 = lds + ((kt + 1) & 1) * STAGE;
      u16* B2 = A2 + 128 * 32;
#pragma unroll
      for (int i = 0; i < 2; i++) *(u32x4*)(A2 + (tid + i * 256) * 8) = ra[i];
#pragma unroll
      for (int i = 0; i < 4; i++) *(u32x4*)(B2 + (tid + i * 256) * 8) = rb[i];
    }
    __builtin_amdgcn_sched_barrier(0);
#pragma unroll
    for (int j = 4; j < 8; j++)
#pragma unroll
      for (int i = 0; i < 4; i++) acc[i][j] = __builtin_amdgcn_mfma_f32_16x16x32_bf16(af[i], bfr[j], acc[i][j], 0, 0, 0);
    __builtin_amdgcn_s_setprio(0);
    __syncthreads();
  }
}
#define ACC_COLW(j) (wn * 128 + (j) * 16 + l15)

#define ACC_ROW(i, e) (wm * 64 + (i) * 16 + quad * 4 + (e))
#define ACC_COL(BN, j) (wn * ((BN) / 2) + (j) * 16 + l15)

template <int BN>
DEV void acc_to_lds(f32x4 (&acc)[4][BN / 32], float* st) {
  const int tid = opaque_tid(), lane = tid & 63, w = tid >> 6, l15 = lane & 15, quad = lane >> 4;
  const int wm = w >> 1, wn = w & 1;
#pragma unroll
  for (int i = 0; i < 4; i++)
#pragma unroll
    for (int j = 0; j < BN / 32; j++)
#pragma unroll
      for (int e = 0; e < 4; e++) st[ACC_ROW(i, e) * (BN + 1) + ACC_COL(BN, j)] = acc[i][j][e];
}

template <int DQ, bool NA>
DEV void attn_item(const u16* __restrict__ Qb, const u16* __restrict__ Kb, const u16* __restrict__ Vt, int q0, int t0,
                   int n0, int t1, int n1, float sc2, float mref2, u16* __restrict__ Op, int r0, const float* __restrict__ rpbh,
                   u16* lds, float* rpb_lds) {
  constexpr int NDC = DQ / 32;
  constexpr int KT = 64 * DQ, VT = 64 * 64, STAGE = KT + VT;
#define KOFF(row, kc) (((kc) < 8) ? ((row) * 64 + ((((kc) ^ (((row) >> 1) & 7))) * 8)) : (4096 + (row) * 32 + ((kc) - 8) * 8))
#define VOFF(dv, kc) ((dv) * 64 + ((((kc) ^ (((dv) >> 1) & 7))) * 8))
  constexpr int CPR = DQ / 8;
  constexpr int NKI = (64 * CPR) / 256;
  const int tid = opaque_tid(), lane = tid & 63, w = tid >> 6, l15 = lane & 15, quad = lane >> 4;
  __syncthreads();
  if (NA) {
    for (int i = tid; i < 465; i += 256) rpb_lds[i] = rpbh[i] * (LOG2E / sc2);
  }
  bf16x8 qf[2][NDC];
#pragma unroll
  for (int qg = 0; qg < 2; qg++)
#pragma unroll
    for (int dc = 0; dc < NDC; dc++)
      qf[qg][dc] = *(const bf16x8*)(Qb + (size_t)(q0 + w * 32 + qg * 16 + l15) * DQ + dc * 32 + quad * 8);
  u32x4 rk[NKI], rv[2];
  const int nt = n0 + n1;
  f32x4 o[4][2];
#pragma unroll
  for (int dg = 0; dg < 4; dg++)
#pragma unroll
    for (int qg = 0; qg < 2; qg++) o[dg][qg] = f32x4{0.f, 0.f, 0.f, 0.f};
  float lrun[2] = {0.f, 0.f};
  f32x4 zero4 = f32x4{0.f, 0.f, 0.f, 0.f};
  asm volatile("" : "+v"(zero4));

  {
    const int t = (0 < n0) ? t0 : t1;
#pragma unroll
    for (int i = 0; i < NKI; i++) {
      int c = tid + i * 256;
      int row = c / CPR, kc = c % CPR;
      rk[i] = *(const u32x4*)(Kb + (size_t)t * (64 * DQ) + (unsigned)(row * DQ + kc * 8));
    }
#pragma unroll
    for (int i = 0; i < 2; i++) {
      int c = tid + i * 256;
      int dv = c >> 3, kc = c & 7;
      rv[i] = *(const u32x4*)(Vt + (size_t)t * 64 + (unsigned)(dv * SS + kc * 8));
    }
    u16* Ks = lds;
    u16* Vs = Ks + KT;
#pragma unroll
    for (int i = 0; i < NKI; i++) {
      int c = tid + i * 256;
      int row = c / CPR, kc = c % CPR;
      *(u32x4*)(Ks + KOFF(row, kc)) = rk[i];
    }
#pragma unroll
    for (int i = 0; i < 2; i++) {
      int c = tid + i * 256;
      int dv = c >> 3, kc = c & 7;
      *(u32x4*)(Vs + VOFF(dv, kc)) = rv[i];
    }
  }
  __syncthreads();
  for (int it = 0; it < nt; it++) {
    const bool more = (it + 1 < nt);
    if (more) {
      const int t = (it + 1 < n0) ? (t0 + it + 1) : (t1 + it + 1 - n0);
#pragma unroll
      for (int i = 0; i < NKI; i++) {
        int c = tid + i * 256;
        int row = c / CPR, kc = c % CPR;
        rk[i] = *(const u32x4*)(Kb + (size_t)t * (64 * DQ) + (unsigned)(row * DQ + kc * 8));
      }
#pragma unroll
      for (int i = 0; i < 2; i++) {
        int c = tid + i * 256;
        int dv = c >> 3, kc = c & 7;
        rv[i] = *(const u32x4*)(Vt + (size_t)t * 64 + (unsigned)(dv * SS + kc * 8));
      }
    }
    const u16* Ks = lds + (it & 1) * STAGE;
    const u16* Vs = Ks + KT;
    f32x4 s[4][2];
    {
      bf16x8 kf[NDC][4];
#pragma unroll
      for (int dc = 0; dc < NDC; dc++)
#pragma unroll
        for (int kg = 0; kg < 4; kg++) kf[dc][kg] = *(const bf16x8*)(Ks + KOFF(kg * 16 + l15, dc * 4 + quad));
#pragma unroll
      for (int kg = 0; kg < 4; kg++)
#pragma unroll
        for (int qg = 0; qg < 2; qg++) s[kg][qg] = __builtin_amdgcn_mfma_f32_16x16x32_bf16(kf[0][kg], qf[qg][0], zero4, 0, 0, 0);
#pragma unroll
      for (int dc = 1; dc < NDC; dc++)
#pragma unroll
        for (int kg = 0; kg < 4; kg++)
#pragma unroll
          for (int qg = 0; qg < 2; qg++) s[kg][qg] = __builtin_amdgcn_mfma_f32_16x16x32_bf16(kf[dc][kg], qf[qg][dc], s[kg][qg], 0, 0, 0);
    }
    bf16x8 vf[2][4];
#pragma unroll
    for (int t2 = 0; t2 < 2; t2++)
#pragma unroll
      for (int dg = 0; dg < 4; dg++) vf[t2][dg] = *(const bf16x8*)(Vs + VOFF(dg * 16 + l15, t2 * 4 + quad));
    if (NA) {
      const bool band = (it >= n0);
      if (band) {
        const int kr = t1 + (it - n0) - 4;
        const int r = r0 + (w >> 1);
        const int rs = clampi(r - 4, 0, 120);
        const bool rowok = (kr >= rs) && (kr < rs + 8);
#pragma unroll
        for (int qg = 0; qg < 2; qg++) {
          const int qc = (w & 1) * 32 + qg * 16 + l15;
          const int cs = clampi(qc - 8, 0, 48);
#pragma unroll
          for (int kg = 0; kg < 4; kg++)
#pragma unroll
            for (int e = 0; e < 4; e++) {
              const int kc = kg * 16 + quad * 4 + e;
              const bool ok = rowok && (kc >= cs) && (kc < cs + 16);
              int bi = (kr - r + 7) * 31 + (kc - qc + 15);
              bi = ok ? bi : 0;
              s[kg][qg][e] = ok ? (s[kg][qg][e] + rpb_lds[bi]) : -1e30f;
            }
        }
      }
    }
#pragma unroll
    for (int qg = 0; qg < 2; qg++) {
      float ps = 0.f;
#pragma unroll
      for (int kg = 0; kg < 4; kg++)
#pragma unroll
        for (int e = 0; e < 4; e++) {
          float pv = __builtin_amdgcn_exp2f(fmaf(s[kg][qg][e], sc2, -mref2));
          s[kg][qg][e] = pv;
          ps += pv;
        }
      lrun[qg] += ps;
    }
#pragma unroll
    for (int t2 = 0; t2 < 2; t2++) {
      bf16x8 pb[2];
#pragma unroll
      for (int qg = 0; qg < 2; qg++) {
        u32x4 cv;
        cv[0] = pack2(s[2 * t2][qg][0], s[2 * t2][qg][1]);
        cv[1] = pack2(s[2 * t2][qg][2], s[2 * t2][qg][3]);
        cv[2] = pack2(s[2 * t2 + 1][qg][0], s[2 * t2 + 1][qg][1]);
        cv[3] = pack2(s[2 * t2 + 1][qg][2], s[2 * t2 + 1][qg][3]);
        pb[qg] = __builtin_bit_cast(bf16x8, cv);
      }
#pragma unroll
      for (int dg = 0; dg < 4; dg++) {
#pragma unroll
        for (int qg = 0; qg < 2; qg++) o[dg][qg] = __builtin_amdgcn_mfma_f32_16x16x32_bf16(vf[t2][dg], pb[qg], o[dg][qg], 0, 0, 0);
      }
    }
    if (more) {
      u16* K2 = lds + ((it + 1) & 1) * STAGE;
      u16* V2 = K2 + KT;
#pragma unroll
      for (int i = 0; i < NKI; i++) {
        int c = tid + i * 256;
        int row = c / CPR, kc = c % CPR;
        *(u32x4*)(K2 + KOFF(row, kc)) = rk[i];
      }
#pragma unroll
      for (int i = 0; i < 2; i++) {
        int c = tid + i * 256;
        int dv = c >> 3, kc = c & 7;
        *(u32x4*)(V2 + VOFF(dv, kc)) = rv[i];
      }
    }
    __syncthreads();
  }
#pragma unroll
  for (int qg = 0; qg < 2; qg++) {
    float l = lrun[qg];
    l += shfl_xor_f(l, 16);
    l += shfl_xor_f(l, 32);
    const float inv = 1.f / l;
    u16* dst = Op + (size_t)(w * 32 + qg * 16 + l15) * 1024 + quad * 4;
#pragma unroll
    for (int dg = 0; dg < 4; dg++) {
      uint2 v;
      v.x = pack2(o[dg][qg][0] * inv, o[dg][qg][1] * inv);
      v.y = pack2(o[dg][qg][2] * inv, o[dg][qg][3] * inv);
      *(uint2*)(dst + dg * 16) = v;
    }
  }
}
#undef KOFF
#undef VOFF

DEV void conv_tile(const float* __restrict__ src, int K, int N, u16* __restrict__ dst, int kt, int nt, float* lds, const float* __restrict__ kscale) {
  const int tid = opaque_tid();
  __syncthreads();
  {
    float4 v[4];
    const int n4 = (tid & 15) * 4;
    const int gn = nt * 64 + n4;
#pragma unroll
    for (int i = 0; i < 4; i++) {
      const int k = i * 16 + (tid >> 4);
      v[i] = (gn < N) ? *(const float4*)(src + (size_t)(kt * 64 + k) * N + gn) : make_float4(0.f, 0.f, 0.f, 0.f);
      if (kscale) { const float ks = kscale[kt * 64 + k]; v[i].x *= ks; v[i].y *= ks; v[i].z *= ks; v[i].w *= ks; }
    }
#pragma unroll
    for (int i = 0; i < 4; i++) {
      const int k = i * 16 + (tid >> 4);
      float* d = lds + k * 65 + n4;
      d[0] = v[i].x; d[1] = v[i].y; d[2] = v[i].z; d[3] = v[i].w;
    }
  }
  __syncthreads();
#pragma unroll
  for (int i = 0; i < 2; i++) {
    const int c = tid + i * 256;
    const int nn = c >> 3, k8 = (c & 7) * 8;
    float f[8];
#pragma unroll
    for (int e = 0; e < 8; e++) f[e] = lds[(k8 + e) * 65 + nn];
    store8(dst + (size_t)(nt * 64 + nn) * K + kt * 64 + k8, f);
  }
}

constexpr int NCT = 4272;

DEV void phase0(const Params& p, int vb, int G, char* smem) {
  float* ldsf = (float*)smem;
  const int tid = opaque_tid();
  const int total = 2 * NCT + 128 + 192 + 1;
  for (int it0 = vb; it0 < total; it0 += G) {
    const int it = (it0 < 192) ? (2 * NCT + 128 + it0) : ((it0 < 192 + 2 * NCT + 128) ? (it0 - 192) : it0);
    if (it < 2 * NCT) {
      const int l = it / NCT;
      int idx = it - l * NCT;
      u16* W = (u16*)(p.ws + WS_W) + (size_t)l * WL;
      const float* src; u16* dst; int K, N, kt, nt; const float* kscale = nullptr;
      if (idx < 576) { K = 1024; N = 2272; nt = idx >> 4; kt = idx & 15; src = p.in[6] + (size_t)l * 1024 * 2272; dst = W + OW_IN; }
      else if ((idx -= 576) < 1024) { int i = idx >> 8, r = idx & 255; K = 1024; N = 1024; nt = r >> 4; kt = r & 15; src = p.in[22] + (size_t)(l * 4 + i) * 1048576; dst = W + OW_GATE + (size_t)i * 1048576; }
      else if ((idx -= 1024) < 256) { int i = idx >> 6, r = idx & 63; K = 256; N = 1024; nt = r >> 2; kt = r & 3; src = p.in[21] + (size_t)(l * 4 + i) * 262144; dst = W + OW_BRANCH + (size_t)i * 262144; }
      else if ((idx -= 256) < 256) { K = 1024; N = 1024; nt = idx >> 4; kt = idx & 15; src = p.in[24] + (size_t)l * 1048576; dst = W + OW_OUT; }
      else if ((idx -= 256) < 1408) { K = 1024; N = 5632; nt = idx >> 4; kt = idx & 15; src = p.in[25] + (size_t)l * 1024 * 5632; dst = W + OW_UP; }
      else if ((idx -= 1408) < 704) { K = 2816; N = 1024; nt = idx / 44; kt = idx % 44; src = p.in[28] + (size_t)l * 2816 * 1024; dst = W + OW_DOWN; }
      else if ((idx -= 704) < 24) { K = 256; N = 384; nt = idx >> 2; kt = idx & 3; src = p.in[12] + (size_t)l * 256 * 384; dst = W + OW_UQ; kscale = p.in[10] + l * 256; }
      else { idx -= 24; K = 192; N = 512; nt = idx / 3; kt = idx % 3; src = p.in[13] + (size_t)l * 192 * 512; dst = W + OW_UKV; kscale = p.in[11] + l * 192; }
      conv_tile(src, K, N, dst, kt, nt, ldsf, kscale);
    } else if (it < 2 * NCT + 128) {
      const int j = it - 2 * NCT;
      const int l = j >> 6, ch = j & 63;
      const float* src = p.in[17] + (size_t)l * 65536 + ch * 1024;
      u16* dst = (u16*)(p.ws + WS_W) + (size_t)l * WL + OW_SG + ch * 1024;
      float4 v = *(const float4*)(src + tid * 4);
      uint2 o; o.x = pack2(v.x, v.y); o.y = pack2(v.z, v.w);
      *(uint2*)(dst + tid * 4) = o;
    } else if (it < 2 * NCT + 128 + 192) {
      const int j = it - (2 * NCT + 128);
      const int l = j / 96, cb = j % 96;
      __syncthreads();
      float* sc = ldsf;
      float* red = ldsf + 5120;
      for (int i = tid; i < 5120; i += 256) {
        int m = i >> 10, k = i & 1023;
        float c = (m < 4) ? p.in[1][m * 1024 + k] : p.in[3][k];
        sc[i] = silu_f(c);
      }
      __syncthreads();
      const int kg = tid >> 6, n = tid & 63;
      const float* wsrc = p.in[4] + (size_t)l * 1024 * 6144 + cb * 64 + n;
      float a0 = 0, a1 = 0, a2 = 0, a3 = 0, a4 = 0;
#pragma unroll 8
      for (int k = kg * 256; k < kg * 256 + 256; k++) {
        float wv = wsrc[(size_t)k * 6144];
        a0 += sc[k] * wv; a1 += sc[1024 + k] * wv; a2 += sc[2048 + k] * wv; a3 += sc[3072 + k] * wv; a4 += sc[4096 + k] * wv;
      }
      red[(kg * 5 + 0) * 64 + n] = a0; red[(kg * 5 + 1) * 64 + n] = a1; red[(kg * 5 + 2) * 64 + n] = a2;
      red[(kg * 5 + 3) * 64 + n] = a3; red[(kg * 5 + 4) * 64 + n] = a4;
      __syncthreads();
      for (int i = tid; i < 320; i += 256) {
        int m = i >> 6, nn = i & 63;
        float v = red[(0 * 5 + m) * 64 + nn] + red[(1 * 5 + m) * 64 + nn] + red[(2 * 5 + m) * 64 + nn] + red[(3 * 5 + m) * 64 + nn];
        v += p.in[5][(size_t)l * 6144 + cb * 64 + nn];
        ((float*)(p.ws + WS_MOD))[(size_t)(l * 5 + m) * 6144 + cb * 64 + nn] = v;
      }
    } else {
      float2* r16 = (float2*)(p.ws + WS_R16);
      float2* r8 = (float2*)(p.ws + WS_R8);
      for (int i = tid; i < 1024; i += 256) ((unsigned*)(p.ws + WS_ZROW))[i] = 0u;
      for (int i = tid; i < 2048; i += 256) {
        int pos = i >> 4, k = i & 15;
        float inv = powf(10000.f, -(float)k / 16.f);
        float ang = (float)pos * inv;
        r16[i] = make_float2(cosf(ang), sinf(ang));
      }
      for (int i = tid; i < 1024; i += 256) {
        int pos = i >> 3, k = i & 7;
        float inv = powf(10000.f, -(float)k / 8.f);
        float ang = (float)pos * inv;
        r8[i] = make_float2(cosf(ang), sinf(ang));
      }
    }
  }
}

DEV void phase_modulate(const XMap& xin, const float* __restrict__ modl, int shi, int sci, u16* __restrict__ H,
                        bool skip_ctx, int vb, int G) {
  const int tid = opaque_tid(), lane = tid & 63, w = tid >> 6;
  for (int m = vb * 4 + w; m < MM; m += G * 4) {
    const int b = m / SS, s = m - b * SS;
    if (skip_ctx && s < CC) continue;
    const int mrow = (s < CC) ? 4 : b;
    const float* xr = xrow(xin, m);
    float4 v[4];
    float ss = 0.f;
#pragma unroll
    for (int i = 0; i < 4; i++) {
      v[i] = *(const float4*)(xr + i * 256 + lane * 4);
      ss += v[i].x * v[i].x + v[i].y * v[i].y + v[i].z * v[i].z + v[i].w * v[i].w;
    }
#pragma unroll
    for (int o = 32; o >= 1; o >>= 1) ss += shfl_xor_f(ss, o);
    const float rstd = rsqrtf(ss * (1.f / 1024.f) + EPS);
    const float* sh = modl + (size_t)mrow * 6144 + shi * 1024;
    const float* sc = modl + (size_t)mrow * 6144 + sci * 1024;
#pragma unroll
    for (int i = 0; i < 4; i++) {
      const int n = i * 256 + lane * 4;
      float4 a = *(const float4*)(sc + n);
      float4 c = *(const float4*)(sh + n);
      uint2 o;
      o.x = pack2(v[i].x * rstd * (1.f + a.x) + c.x, v[i].y * rstd * (1.f + a.y) + c.y);
      o.y = pack2(v[i].z * rstd * (1.f + a.z) + c.z, v[i].w * rstd * (1.f + a.w) + c.w);
      *(uint2*)(H + (size_t)m * DD + n) = o;
    }
  }
}

DEV void unpack8(const u32x4& v, float (&f)[8]) {
  f[0] = __uint_as_float(v[0] << 16); f[1] = __uint_as_float(v[0] & 0xffff0000u);
  f[2] = __uint_as_float(v[1] << 16); f[3] = __uint_as_float(v[1] & 0xffff0000u);
  f[4] = __uint_as_float(v[2] << 16); f[5] = __uint_as_float(v[2] & 0xffff0000u);
  f[6] = __uint_as_float(v[3] << 16); f[7] = __uint_as_float(v[3] & 0xffff0000u);
}

DEV void head_norm64(float (&v)[8], const float* __restrict__ gain, int c, bool rope, int s, const float2* __restrict__ R16) {
  float ss = 0.f;
#pragma unroll
  for (int e = 0; e < 8; e++) ss += v[e] * v[e];
  ss += shfl_xor_f(ss, 1); ss += shfl_xor_f(ss, 2); ss += shfl_xor_f(ss, 4);
  const float rstd = rsqrtf(ss * (1.f / 64.f) + EPS);
#pragma unroll
  for (int e = 0; e < 8; e++) v[e] *= rstd * gain[c * 8 + e];
  if (rope) {
    const int tl = s - CC;
    const int pos = (c & 4) ? (tl & 63) : (tl >> 6);
#pragma unroll
    for (int e = 0; e < 8; e++) {
      float pr = shfl_xor_f(v[e], 2);
      float2 cs = R16[pos * 16 + (c & 1) * 8 + e];
      v[e] = (c & 2) ? (v[e] * cs.x + pr * cs.y) : (v[e] * cs.x - pr * cs.y);
    }
  }
}

DEV void prep_item(const Params& p, int l, int it, char* smem) {
  u16* Z = (u16*)(p.ws + WS_Z);
  u16* QKV = (u16*)(p.ws + WS_QKV);
  const float2* R16 = (const float2*)(p.ws + WS_R16);
  const float2* R8 = (const float2*)(p.ws + WS_R8);
  float* rstd_l = (float*)smem;
  const float* na_qn = p.in[7] + l * 64;
  const float* na_kn = p.in[8] + l * 64;
  const float* cq_n = p.in[10] + l * 256;
  const float* ckv_n = p.in[11] + l * 192;
  const float* mla_kn = p.in[15] + l * 96;
  const float* sgv_n = p.in[16] + l * 256;
  const float* gq_qn = p.in[19] + l * 64;
  const float* gq_kn = p.in[20] + l * 64;
  {
    const int tid = opaque_tid(), lane = tid & 63, w = tid >> 6;
    const int part = it % 3;
    const int m0 = (it / 3) * 64;
    const int b = m0 / SS, s0 = m0 - b * SS;
    const bool latent = (s0 >= CC);
    if (part == 0) {
      const int c = tid & 7;
#pragma unroll
      for (int g = 0; g < 2; g++) {
        u32x4 raw[4][2];
#pragma unroll
        for (int h = 0; h < 4; h++)
#pragma unroll
          for (int rep = 0; rep < 2; rep++)
            raw[h][rep] = *(const u32x4*)(Z + (size_t)(m0 + rep * 32 + (tid >> 3)) * ZW + g * 256 + h * 64 + c * 8);
        const float* gain = g ? na_kn : na_qn;
#pragma unroll
        for (int h = 0; h < 4; h++)
#pragma unroll
          for (int rep = 0; rep < 2; rep++) {
            const int s = s0 + rep * 32 + (tid >> 3);
            float v[8];
            unpack8(raw[h][rep], v);
            head_norm64(v, gain, c, false, s, R16);
            store8(QKV + (g ? K_NA : Q_NA) + ((size_t)(b * 4 + h) * SS + s) * 64 + c * 8, v);
          }
      }
    } else if (part == 1) {
      const int c = tid & 7;
      {
        u32x4 raw[6][2];
#pragma unroll
        for (int h = 0; h < 6; h++)
#pragma unroll
          for (int rep = 0; rep < 2; rep++)
            raw[h][rep] = *(const u32x4*)(Z + (size_t)(m0 + rep * 32 + (tid >> 3)) * ZW + 1760 + h * 64 + c * 8);
#pragma unroll
        for (int h = 0; h < 6; h++)
#pragma unroll
          for (int rep = 0; rep < 2; rep++) {
            const int s = s0 + rep * 32 + (tid >> 3);
            float v[8];
            unpack8(raw[h][rep], v);
            head_norm64(v, (h < 4) ? gq_qn : gq_kn, c, latent, s, R16);
            u16* dst = (h < 4) ? (QKV + Q_GQA + ((size_t)(b * 4 + h) * SS + s) * 64) : (QKV + K_GQA + ((size_t)(b * 2 + (h - 4)) * SS + s) * 64);
            store8(dst + c * 8, v);
          }
      }
      const int sp = perm32(s0 + lane);
#pragma unroll
      for (int k3 = 0; k3 < 3; k3++) {
        u32x4 raw[4];
#pragma unroll
        for (int q = 0; q < 4; q++) {
          const int ct = w + 4 * (k3 * 4 + q);
          const int srccol = (ct < 32) ? (512 + ct * 8) : (2144 + (ct - 32) * 8);
          raw[q] = *(const u32x4*)(Z + (size_t)(m0 + lane) * ZW + srccol);
        }
#pragma unroll
        for (int q = 0; q < 4; q++) {
          const int ct = w + 4 * (k3 * 4 + q);
          u16* dst;
          if (ct < 32) { int head = ct >> 3, dv0 = (ct & 7) * 8; dst = QKV + V_NA + ((size_t)(b * 4 + head) * 64 + dv0) * SS; }
          else { int cg2 = ct - 32; int head = cg2 >> 3, dv0 = (cg2 & 7) * 8; dst = QKV + V_GQA + ((size_t)(b * 2 + head) * 64 + dv0) * SS; }
          dst += sp;
#pragma unroll
          for (int e = 0; e < 4; e++) {
            dst[(size_t)(2 * e) * SS] = (u16)(raw[q][e] & 0xffff);
            dst[(size_t)(2 * e + 1) * SS] = (u16)(raw[q][e] >> 16);
          }
        }
      }
    } else if (part == 2) {
      __syncthreads();
#pragma unroll
      for (int hb = 0; hb < 2; hb++) {
        u32x4 ru[4], rv2[4];
#pragma unroll
        for (int q = 0; q < 4; q++) {
          const int idx = (hb * 4 + q) * 256 + tid;
          const int t = idx >> 5, c = idx & 31;
          ru[q] = *(const u32x4*)(Z + (size_t)(m0 + t) * ZW + 1248 + c * 8);
          rv2[q] = *(const u32x4*)(Z + (size_t)(m0 + t) * ZW + 1504 + c * 8);
        }
#pragma unroll
        for (int q = 0; q < 4; q++) {
          const int idx = (hb * 4 + q) * 256 + tid;
          const int t = idx >> 5, c = idx & 31;
          float v[8];
          unpack8(ru[q], v);
#pragma unroll
          for (int e = 0; e < 8; e++) v[e] = gelu_f(v[e]);
          store8(QKV + SG_U + (size_t)(m0 + t) * 256 + c * 8, v);
          unpack8(rv2[q], v);
          float ss = 0.f;
#pragma unroll
          for (int e = 0; e < 8; e++) { float g = gelu_f(v[e]); ss += g * g; }
#pragma unroll
          for (int o = 1; o <= 16; o <<= 1) ss += shfl_xor_f(ss, o);
          if (c == 0) rstd_l[t] = rsqrtf(ss * (1.f / 256.f) + EPS);
        }
      }
      __syncthreads();
      {
        u32x4 raw[8];
#pragma unroll
        for (int q = 0; q < 8; q++) raw[q] = *(const u32x4*)(Z + (size_t)(m0 + lane) * ZW + 1504 + (w + 4 * q) * 8);
        const float rs = rstd_l[lane];
        const int mm = m0 + lane;
#pragma unroll
        for (int q = 0; q < 8; q++) {
          const int ct = w + 4 * q;
          float v[8];
          unpack8(raw[q], v);
          u16* dst = QKV + SG_VT + (size_t)(mm >> 7) * 32768 + (size_t)(ct * 8) * 128 + (mm & 127);
#pragma unroll
          for (int e = 0; e < 8; e++) dst[e * 128] = f2bf(gelu_f(v[e]) * rs * sgv_n[ct * 8 + e]);
        }
      }
    }
  }
}

#define XB_TMO      128
#define XB_XCNT(j)  (256  + 64 * (j))
#define XB_XSUB(j)  (1280 + 64 * (j))
#define XB_XGEN(j)  (2304 + 64 * (j))
#define XB_TOP      3328
#define XB_TOPGEN   3392
#define XCD_BAR_WORDS 3456
#define XB_SPIN_CAP (1u << 18)
#define LAS __attribute__((address_space(3)))

__device__ __forceinline__ unsigned xb_ld(unsigned* p)              { return __hip_atomic_load(p, __ATOMIC_RELAXED, __HIP_MEMORY_SCOPE_AGENT); }
__device__ __forceinline__ unsigned xb_add(unsigned* p, unsigned v) { return __hip_atomic_fetch_add(p, v, __ATOMIC_RELAXED, __HIP_MEMORY_SCOPE_AGENT); }
__device__ __forceinline__ unsigned xb_xcc_id() { return (unsigned)__builtin_amdgcn_s_getreg((3 << 11) | 20) & 0xFu; }
#define XB_SPIN(cond, bar) do { unsigned _sp = 0; while (cond) { __builtin_amdgcn_s_sleep(1); \
    if ((++_sp & 255u) == 0u) { if (xb_ld(&(bar)[XB_TMO])) break; if (_sp > XB_SPIN_CAP) { atomicAdd(&(bar)[XB_TMO], 1u); break; } } } } while (0)

struct XcdBarrier {
    unsigned* bar; unsigned x;
    volatile LAS unsigned* st;
};

__device__ __forceinline__ XcdBarrier xcd_barrier_post(unsigned* bar, volatile LAS unsigned* st) {
    XcdBarrier b; b.bar = bar; b.x = (unsigned)__builtin_amdgcn_readfirstlane((int)xb_xcc_id()); b.st = st;
    if (threadIdx.x == 0) (void)xb_add(&bar[XB_XCNT(b.x)], 1u);
    return b;
}
__device__ __forceinline__ void xcd_barrier_complete(unsigned* bar, unsigned x, unsigned& nloc, unsigned& nx) {
    const unsigned G = gridDim.x * gridDim.y * gridDim.z;
    unsigned sum, cnt, mine, sp = 0u;
    for (;;) {
        sum = 0u; cnt = 0u; mine = 0u;
#pragma unroll
        for (unsigned j = 0; j < 16; ++j) { const unsigned c = xb_ld(&bar[XB_XCNT(j)]); sum += c; cnt += (c > 0u) ? 1u : 0u; mine = (j == x) ? c : mine; }
        if (sum == G) break;
        __builtin_amdgcn_s_sleep(1);
        if ((++sp & 255u) == 0u) { if (xb_ld(&bar[XB_TMO])) break; if (sp > XB_SPIN_CAP) { atomicAdd(&bar[XB_TMO], 1u); break; } }
    }
    nloc = mine > 0u ? mine : 1u; nx = cnt > 0u ? cnt : 1u;
}

__device__ __forceinline__ void xcd_barrier(const XcdBarrier& b) {
    asm volatile("s_waitcnt vmcnt(0)" ::: "memory");
    __syncthreads();
    if (threadIdx.x == 0) {
        unsigned* bar = b.bar;
        __builtin_amdgcn_s_waitcnt(0);
        unsigned nloc = b.st[0], nx = b.st[1];
        if (nloc == 0u) { xcd_barrier_complete(bar, b.x, nloc, nx); b.st[0] = nloc; b.st[1] = nx; }
        const unsigned old = xb_add(&bar[XB_XSUB(b.x)], 1u);
        const unsigned gen = old / nloc;
        if (old + 1u == (gen + 1u) * nloc) {
            __builtin_amdgcn_fence(__ATOMIC_RELEASE, "agent");
            asm volatile("s_waitcnt vmcnt(0)" ::: "memory");
            const unsigned og = xb_add(&bar[XB_TOP], 1u);
            const unsigned tg = og / nx;
            if (og + 1u == (tg + 1u) * nx) xb_add(&bar[XB_TOPGEN], 1u);
            else XB_SPIN(xb_ld(&bar[XB_TOPGEN]) == tg, bar);
            __builtin_amdgcn_fence(__ATOMIC_ACQUIRE, "agent");
            xb_add(&bar[XB_XGEN(b.x)], 1u);
            asm volatile("s_waitcnt vmcnt(0)" ::: "memory");
        } else {
            XB_SPIN(xb_ld(&bar[XB_XGEN(b.x)]) == gen, bar);
            __builtin_amdgcn_fence(__ATOMIC_ACQUIRE, "agent");
            asm volatile("s_waitcnt vmcnt(0)" ::: "memory");
        }
    }
    __syncthreads();
}


__global__ void __launch_bounds__(256, 2) fwd_megakernel(Params p) {
  __shared__ __attribute__((aligned(16))) char smem[SMEM_BYTES];
  cg::grid_group grid = cg::this_grid();
  __shared__ __attribute__((aligned(16))) unsigned xb_st[4];
  if (threadIdx.x < 4) xb_st[threadIdx.x] = 0u;
  __syncthreads();
  XcdBarrier xbar = xcd_barrier_post((unsigned*)(p.ws + WS_BAR), (volatile LAS unsigned*)xb_st);
  const int G = gridDim.x;
  const int vb = ((G & 7) == 0) ? ((blockIdx.x & 7) * (G >> 3) + (blockIdx.x >> 3)) : (int)blockIdx.x;
  const int tid = opaque_tid(), lane = tid & 63, w = tid >> 6, l15 = lane & 15, quad = lane >> 4;
  const int wm = w >> 1, wn = w & 1;
  u16* ldsu = (u16*)smem;
  float* ldsf = (float*)smem;

  u16* H = (u16*)(p.ws + WS_H);
  u16* Z = (u16*)(p.ws + WS_Z);
  u16* O = Z;
  u16* Y = Z + (size_t)MM * 1024;
  u16* QKV = (u16*)(p.ws + WS_QKV);
  u16* ACT = QKV;
  const float2* R8 = (const float2*)(p.ws + WS_R8);

  for (int rep_ = 0; rep_ < REP_SYNC; rep_++) grid.sync();
#ifndef SKIP_P0
  for (int rep_ = 0; rep_ < REP_P0; rep_++) phase0(p, vb, G, smem);
#endif
  if (gridDim.y > 1) grid.sync();

  for (int l = 0; l < 2; l++) {
    xcd_barrier(xbar);
    const u16* W = (const u16*)(p.ws + WS_W) + (size_t)l * WL;
    const float* modl = (const float*)(p.ws + WS_MOD) + (size_t)l * 5 * 6144;
    XMap xin, xout;
    if (l == 0) { xin.lat = (float*)p.in[0]; xin.ctx = (float*)p.in[2]; }
    else { xin.lat = p.out; xin.ctx = (float*)(p.ws + WS_CX); }
    xout.lat = p.out; xout.ctx = (float*)(p.ws + WS_CX);
    const bool last = (l == 1);

#ifndef SKIP_P1
    for (int rep_ = 0; rep_ < REP_P1; rep_++) {
    phase_modulate(xin, modl, 0, 1, H, false, vb, G);
    }
#endif
    xcd_barrier(xbar);

#ifndef SKIP_P2
    {
    for (int rep_ = 0; rep_ < REP_P2; rep_++) {
    const int tid = opaque_tid(), lane = tid & 63, w = tid >> 6, l15 = lane & 15, quad = lane >> 4;
    const int wm = w >> 1, wn = w & 1;
    (void)wm; (void)wn; (void)l15; (void)quad;
    for (int it = vb; it < 264 * 9; it += G) {
      const int g8 = it / (8 * 9);
      const int rem = it - g8 * (8 * 9);
      const int nt = rem >> 3;
      const int mt = g8 * 8 + (rem & 7);
      const int m0 = mt * 128, n0 = nt * 256;
      f32x4 acc[4][8];
      gemm_wide([&](int r) { return (const u16*)(H + (size_t)(m0 + r) * DD); },
                [&](int n) { return (const u16*)(W + OW_IN + (size_t)(n0 + n) * 1024); }, 32, acc, ldsu);
      const int tid = opaque_tid(), lane = tid & 63, w = tid >> 6, l15 = lane & 15, quad = lane >> 4, wm = w >> 1, wn = w & 1; (void)lane; (void)wm; (void)wn; (void)l15; (void)quad;
      u16* zb = Z + (size_t)m0 * ZW + n0;
#pragma unroll
      for (int i = 0; i < 4; i++)
#pragma unroll
        for (int j = 0; j < 8; j++)
#pragma unroll
          for (int e = 0; e < 4; e++) zb[ACC_ROW(i, e) * ZW + ACC_COLW(j)] = f2bf(acc[i][j][e]);
    }
    }
    }
#endif
    xcd_barrier(xbar);

#ifndef SKIP_P4
    {
    for (int rep_ = 0; rep_ < REP_P4; rep_++) {
    const int tid = opaque_tid(), lane = tid & 63, w = tid >> 6, l15 = lane & 15, quad = lane >> 4;
    const int wm = w >> 1, wn = w & 1;
    (void)wm; (void)wn; (void)l15; (void)quad;
    {
      const float* mla_qn = p.in[14] + l * 96;
      const float* mla_kn = p.in[15] + l * 96;
      for (int it = vb; it < 264 * 8 + (MM / 64) * 3; it += G) {
        if (it >= 264 * 8) { prep_item(p, l, it - 264 * 8, smem); continue; }
        const int mt = it >> 3, hh = it & 7;
        const int m0 = mt * 128;
        const int b = m0 / SS, s0 = m0 - b * SS;
        if (hh < 4) {
          const int h = hh;
          f32x4 acc[4][3];
          gemm_core<96>([&](int r) { return (const u16*)(Z + (size_t)(m0 + r) * ZW + 768); },
                        [&](int n) { return (const u16*)(W + OW_UQ + (size_t)(h * 96 + n) * 256); }, 4, acc, ldsu);
      const int tid = opaque_tid(), lane = tid & 63, w = tid >> 6, l15 = lane & 15, quad = lane >> 4, wm = w >> 1, wn = w & 1; (void)lane; (void)wm; (void)wn; (void)l15; (void)quad;
          acc_to_lds<96>(acc, ldsf);
          __syncthreads();
          const int t = tid >> 1, hs = tid & 1;
          const int s = s0 + t;
          u16* dst = QKV + Q_MLA + ((size_t)(b * 4 + h) * SS + s) * 96;
          const float* st = ldsf + t * 97;
          float rq;
          {
            const u16* zr = Z + (size_t)(m0 + t) * ZW + 768 + hs * 128;
            u32x4 raw[16];
#pragma unroll
            for (int c = 0; c < 16; c++) raw[c] = *(const u32x4*)(zr + c * 8);
            float sq = 0.f;
#pragma unroll
            for (int c = 0; c < 16; c++) {
              float v[8];
              unpack8(raw[c], v);
#pragma unroll
              for (int e = 0; e < 8; e++) sq += v[e] * v[e];
            }
            sq += shfl_xor_f(sq, 1);
            rq = rsqrtf(sq * (1.f / 256.f) + EPS);
          }
          if (hs == 0) {
            float ss = 0.f;
#pragma unroll
            for (int e = 0; e < 64; e++) ss += st[e] * st[e];
            ss *= rq * rq;
            const float rstd = rq * rsqrtf(ss * (1.f / 64.f) + EPS);
#pragma unroll
            for (int c = 0; c < 8; c++) {
              float v[8];
#pragma unroll
              for (int e = 0; e < 8; e++) v[e] = st[c * 8 + e] * rstd * mla_qn[c * 8 + e];
              store8(dst + c * 8, v);
            }
          } else {
            float ss = 0.f;
#pragma unroll
            for (int e = 0; e < 32; e++) ss += st[64 + e] * st[64 + e];
            ss *= rq * rq;
            const float rstd = rq * rsqrtf(ss * (1.f / 32.f) + EPS);
            float x1[8], x2[8], y1[8], y2[8];
#pragma unroll
            for (int e = 0; e < 8; e++) {
              x1[e] = st[64 + e] * rstd * mla_qn[64 + e];
              x2[e] = st[72 + e] * rstd * mla_qn[72 + e];
              y1[e] = st[80 + e] * rstd * mla_qn[80 + e];
              y2[e] = st[88 + e] * rstd * mla_qn[88 + e];
            }
            if (s >= CC) {
              const int tl = s - CC;
              const int prow = tl >> 6, pcol = tl & 63;
#pragma unroll
              for (int e = 0; e < 8; e++) {
                float2 cr = R8[prow * 8 + e];
                float2 cc = R8[pcol * 8 + e];
                float a1 = x1[e] * cr.x - x2[e] * cr.y;
                float a2 = x2[e] * cr.x + x1[e] * cr.y;
                float b1 = y1[e] * cc.x - y2[e] * cc.y;
                float b2 = y2[e] * cc.x + y1[e] * cc.y;
                x1[e] = a1; x2[e] = a2; y1[e] = b1; y2[e] = b2;
              }
            }
            store8(dst + 64, x1); store8(dst + 72, x2); store8(dst + 80, y1); store8(dst + 88, y2);
          }
        } else {
          const int h = hh - 4;
          f32x4 acc[4][4];
          gemm_core<128>([&](int r) { return (const u16*)(Z + (size_t)(m0 + r) * ZW + 1024); },
                         [&](int n) { return (const u16*)(W + OW_UKV + (size_t)(h * 128 + n) * 192); }, 3, acc, ldsu);
      const int tid = opaque_tid(), lane = tid & 63, w = tid >> 6, l15 = lane & 15, quad = lane >> 4, wm = w >> 1, wn = w & 1; (void)lane; (void)wm; (void)wn; (void)l15; (void)quad;
          acc_to_lds<128>(acc, ldsf);
          __syncthreads();
          float* rs_l = ldsf + 128 * 129;
          {
            const int t = tid >> 1, hs = tid & 1;
            const int s = s0 + t;
            float rkv;
            {
              const u16* zr = Z + (size_t)(m0 + t) * ZW + 1024 + hs * 96;
              u32x4 raw[12];
#pragma unroll
              for (int c = 0; c < 12; c++) raw[c] = *(const u32x4*)(zr + c * 8);
              float sq = 0.f;
#pragma unroll
              for (int c = 0; c < 12; c++) {
                float v[8];
                unpack8(raw[c], v);
#pragma unroll
                for (int e = 0; e < 8; e++) sq += v[e] * v[e];
              }
              sq += shfl_xor_f(sq, 1);
              rkv = rsqrtf(sq * (1.f / 192.f) + EPS);
            }
            if (hs == 1) {
              float x1[8], x2[8], y1[8], y2[8];
              const u16* zk = Z + (size_t)(m0 + t) * ZW + 1216;
              load8(zk, x1); load8(zk + 8, x2); load8(zk + 16, y1); load8(zk + 24, y2);
              float ssr = 0.f;
#pragma unroll
              for (int e = 0; e < 8; e++) ssr += x1[e] * x1[e] + x2[e] * x2[e] + y1[e] * y1[e] + y2[e] * y2[e];
              const float rr = rsqrtf(ssr * (1.f / 32.f) + EPS);
#pragma unroll
              for (int e = 0; e < 8; e++) {
                x1[e] *= rr * mla_kn[64 + e]; x2[e] *= rr * mla_kn[72 + e];
                y1[e] *= rr * mla_kn[80 + e]; y2[e] *= rr * mla_kn[88 + e];
              }
              if (s >= CC) {
                const int tl = s - CC;
                const int prow = tl >> 6, pcol = tl & 63;
#pragma unroll
                for (int e = 0; e < 8; e++) {
                  const float2 cr = R8[prow * 8 + e];
                  const float2 cc2 = R8[pcol * 8 + e];
                  const float a1 = x1[e] * cr.x - x2[e] * cr.y;
                  const float a2 = x2[e] * cr.x + x1[e] * cr.y;
                  const float b1 = y1[e] * cc2.x - y2[e] * cc2.y;
                  const float b2 = y2[e] * cc2.x + y1[e] * cc2.y;
                  x1[e] = a1; x2[e] = a2; y1[e] = b1; y2[e] = b2;
                }
              }
              u16* dstr = QKV + K_MLA + ((size_t)(b * 4 + h) * SS + s) * 96 + 64;
              store8(dstr, x1); store8(dstr + 8, x2); store8(dstr + 16, y1); store8(dstr + 24, y2);
            }
            if (hs == 0) {
              rs_l[t] = rkv;
              const float* st = ldsf + t * 129;
              float ss = 0.f;
#pragma unroll
              for (int e = 0; e < 64; e++) ss += st[e] * st[e];
              ss *= rkv * rkv;
              const float rstd = rkv * rsqrtf(ss * (1.f / 64.f) + EPS);
              u16* dst = QKV + K_MLA + ((size_t)(b * 4 + h) * SS + s) * 96;
#pragma unroll
              for (int c = 0; c < 8; c++) {
                float v[8];
#pragma unroll
                for (int e = 0; e < 8; e++) v[e] = st[c * 8 + e] * rstd * mla_kn[c * 8 + e];
                store8(dst + c * 8, v);
              }
            }
          }
          __syncthreads();
          {
            const int t = tid & 127, half = tid >> 7;
            const int sp = perm32(s0 + t);
            u16* dst = QKV + V_MLA + ((size_t)(b * 4 + h) * 64 + half * 32) * SS + sp;
            const float* st = ldsf + t * 129 + 64 + half * 32;
            const float rkv = rs_l[t];
#pragma unroll 8
            for (int e = 0; e < 32; e++) dst[(size_t)e * SS] = f2bf(st[e] * rkv);
          }
        }
      }
    }
    }
    }
#endif
    xcd_barrier(xbar);

#ifndef SKIP_P6
    {
    for (int rep_ = 0; rep_ < REP_P6; rep_++) {
    const int tid = opaque_tid(), lane = tid & 63, w = tid >> 6, l15 = lane & 15, quad = lane >> 4;
    const int wm = w >> 1, wn = w & 1;
    (void)wm; (void)wn; (void)l15; (void)quad;
    {
      const float sc_mla = 0.10206207261596575f * LOG2E;
      const float sc_64 = 0.125f * LOG2E;
      float* rpb_lds = (float*)(smem + 49152);
      const float* rpb = p.in[9] + (size_t)l * 4 * 465;
      const float* sgb = p.in[18] + (size_t)l * 512;
      const int nctx = last ? 0 : 96;
      float mref_mla, mref_gqa, mref_na;
      {
        float* red = (float*)(smem + 60000);
        __syncthreads();
        if (w == 0) {
          auto amax = [&](const float* v, int lo, int hi) {
            float m = 0.f;
            for (int i = lo + lane; i < hi; i += 64) m = fmaxf(m, fabsf(v[i]));
#pragma unroll
            for (int o = 32; o >= 1; o >>= 1) m = fmaxf(m, shfl_xor_f(m, o));
            return m;
          };
          const float naq = amax(p.in[7] + l * 64, 0, 64), nak = amax(p.in[8] + l * 64, 0, 64);
          const float gqq = amax(p.in[19] + l * 64, 0, 64), gqk = amax(p.in[20] + l * 64, 0, 64);
          const float mq1 = amax(p.in[14] + l * 96, 0, 64), mq2 = amax(p.in[14] + l * 96, 64, 96);
          const float mk1 = amax(p.in[15] + l * 96, 0, 64), mk2 = amax(p.in[15] + l * 96, 64, 96);
          const float rb = amax(rpb, 0, 4 * 465);
          if (lane == 0) {
            red[0] = sqrtf(64.f * mq1 * mq1 + 32.f * mq2 * mq2) * sqrtf(64.f * mk1 * mk1 + 32.f * mk2 * mk2) * 0.10206207261596575f * LOG2E;
            red[1] = 8.f * gqq * 8.f * gqk * 0.125f * LOG2E;
            red[2] = (8.f * naq * 8.f * nak * 0.125f + rb) * LOG2E;
          }
        }
        __syncthreads();
        mref_mla = red[0]; mref_gqa = red[1]; mref_na = red[2];
      }
      const int total = 1024 + 1024 + 1024 + 1056 + nctx;
      for (int it = vb; it < total; it += G) {
        int kind;
        const u16* Qp = nullptr; const u16* Kp = nullptr; const u16* Vp = nullptr; u16* Op = nullptr;
        int q0 = 0, t0 = 0, n0 = 0, t1 = 0, n1 = 0, r0 = 0, hsel = 0;
        int sg_ec = 0, sg_g = 0;
        float mref1 = mref_gqa;
        if (it < 3072) {
          const int typ = it >> 10;
          const int j = it & 1023;
          const int qt = j & 63, h = (j >> 6) & 3, b = j >> 8;
          q0 = CC + qt * 128;
          hsel = h;
          if (typ == 0) {
            kind = 0;
            Qp = QKV + Q_MLA + (size_t)(b * 4 + h) * SS * 96; Kp = QKV + K_MLA + (size_t)(b * 4 + h) * SS * 96;
            Vp = QKV + V_MLA + (size_t)(b * 4 + h) * 64 * SS; Op = O + (size_t)(b * SS + q0) * 1024 + 256 + h * 64;
            t0 = 0; n0 = 132;
          } else if (typ == 1) {
            kind = 1;
            const int g = h >> 1;
            Qp = QKV + Q_GQA + (size_t)(b * 4 + h) * SS * 64; Kp = QKV + K_GQA + (size_t)(b * 2 + g) * SS * 64;
            Vp = QKV + V_GQA + (size_t)(b * 2 + g) * 64 * SS; Op = O + (size_t)(b * SS + q0) * 1024 + 768 + h * 64;
            t0 = 0; n0 = 132;
          } else {
            kind = 2;
            r0 = qt * 2;
            const int bs = clampi(r0 - 4, 0, 120);
            const int be = clampi(r0 + 1 - 4, 0, 120) + 8;
            Qp = QKV + Q_NA + (size_t)(b * 4 + h) * SS * 64; Kp = QKV + K_NA + (size_t)(b * 4 + h) * SS * 64;
            Vp = QKV + V_NA + (size_t)(b * 4 + h) * 64 * SS; Op = O + (size_t)(b * SS + q0) * 1024 + 0 + h * 64;
            t0 = 0; n0 = 4; t1 = 4 + bs; n1 = be - bs;
          }
        } else if (it < 3072 + 1056) {
          kind = 3;
          const int j = it - 3072;
          sg_ec = j >> 2; sg_g = j & 3;
        } else {
          const int j = it - (3072 + 1056);
          const int typ = j >> 5, rem = j & 31;
          const int qt = rem & 1, h = (rem >> 1) & 3, b = rem >> 3;
          q0 = qt * 128;
          t0 = 0; n0 = 4;
          if (typ == 1) {
            kind = 0;
            Qp = QKV + Q_MLA + (size_t)(b * 4 + h) * SS * 96; Kp = QKV + K_MLA + (size_t)(b * 4 + h) * SS * 96;
            Vp = QKV + V_MLA + (size_t)(b * 4 + h) * 64 * SS; Op = O + (size_t)(b * SS + q0) * 1024 + 256 + h * 64;
          } else if (typ == 0) {
            kind = 1;
            mref1 = mref_na;
            Qp = QKV + Q_NA + (size_t)(b * 4 + h) * SS * 64; Kp = QKV + K_NA + (size_t)(b * 4 + h) * SS * 64;
            Vp = QKV + V_NA + (size_t)(b * 4 + h) * 64 * SS; Op = O + (size_t)(b * SS + q0) * 1024 + 0 + h * 64;
          } else {
            kind = 1;
            const int g = h >> 1;
            Qp = QKV + Q_GQA + (size_t)(b * 4 + h) * SS * 64; Kp = QKV + K_GQA + (size_t)(b * 2 + g) * SS * 64;
            Vp = QKV + V_GQA + (size_t)(b * 2 + g) * 64 * SS; Op = O + (size_t)(b * SS + q0) * 1024 + 768 + h * 64;
          }
        }
        if (kind == 0) {
#ifndef NO_A96
          attn_item<96, false>(Qp, Kp, Vp, q0, t0, n0, t1, n1, sc_mla, mref_mla, Op, 0, nullptr, ldsu, rpb_lds);
#endif
        } else if (kind == 1) {
#ifndef NO_A64
          attn_item<64, false>(Qp, Kp, Vp, q0, t0, n0, t1, n1, sc_64, mref1, Op, 0, nullptr, ldsu, rpb_lds);
#endif
        } else if (kind == 2) {
#ifndef NO_NA
          attn_item<64, true>(Qp, Kp, Vp, q0, t0, n0, t1, n1, sc_64, mref_na, Op, r0, rpb + hsel * 465, ldsu, rpb_lds);
#endif
        } else {
          const int ec = sg_ec, g = sg_g;
          f32x4 acc[4][2];
          gemm_core<64>([&](int r) { return (const u16*)(W + OW_SG + (size_t)(g * 128 + r) * 128); },
                        [&](int n) { return (const u16*)(QKV + SG_VT + (size_t)ec * 32768 + (size_t)(g * 64 + n) * 128); }, 2, acc, ldsu);
      const int tid = opaque_tid(), lane = tid & 63, w = tid >> 6, l15 = lane & 15, quad = lane >> 4, wm = w >> 1, wn = w & 1; (void)lane; (void)wm; (void)wn; (void)l15; (void)quad;
          asm volatile("" ::: "memory");
          const u16* ub = QKV + SG_U + (size_t)ec * 128 * 256 + g * 64;
          u16* ob = O + (size_t)ec * 128 * 1024 + 512 + g * 64;
          const float* sb = sgb + g * 128;
          float uu[4][2][4];
#pragma unroll
          for (int i = 0; i < 4; i++)
#pragma unroll
            for (int jj = 0; jj < 2; jj++)
#pragma unroll
              for (int e = 0; e < 4; e++) uu[i][jj][e] = bf2f(ub[ACC_ROW(i, e) * 256 + ACC_COL(64, jj)]);
#pragma unroll
          for (int i = 0; i < 4; i++)
#pragma unroll
            for (int e = 0; e < 4; e++) {
              const int pr = ACC_ROW(i, e);
              const float bb = sb[pr];
#pragma unroll
              for (int jj = 0; jj < 2; jj++) ob[pr * 1024 + ACC_COL(64, jj)] = f2bf(uu[i][jj][e] * (acc[i][jj][e] + bb));
            }
        }
      }
    }

    }
    }
#endif
    xcd_barrier(xbar);

#ifndef SKIP_P7
    {
    for (int rep_ = 0; rep_ < REP_P7; rep_++) {
    const int tid = opaque_tid(), lane = tid & 63, w = tid >> 6, l15 = lane & 15, quad = lane >> 4;
    const int wm = w >> 1, wn = w & 1;
    (void)wm; (void)wn; (void)l15; (void)quad;
    {
      const float* bg = p.in[23] + (size_t)l * 4096;
      for (int it = vb; it < (last ? 256 : 264) * 16; it += G) {
        const int mi = it >> 4, nt = it & 15;
        const int mt = last ? ((mi >> 6) * 66 + 2 + (mi & 63)) : mi;
        const int m0 = mt * 128, n0 = nt * 64;
        f32x4 y[4][2];
#pragma unroll
        for (int i = 0; i < 4; i++)
#pragma unroll
          for (int j = 0; j < 2; j++) y[i][j] = f32x4{0.f, 0.f, 0.f, 0.f};
        for (int br = 0; br < 4; br++) {
          f32x4 ag[4][2], ap2[4][2];
          gemm_dual<64>([&](int r) { return (const u16*)(H + (size_t)(m0 + r) * DD); },
                        [&](int n) { return (const u16*)(W + OW_GATE + (size_t)br * 1048576 + (size_t)(n0 + n) * 1024); }, 16, ag,
                        [&](int r) { return (const u16*)(O + (size_t)(m0 + r) * 1024 + br * 256); },
                        [&](int n) { return (const u16*)(W + OW_BRANCH + (size_t)br * 262144 + (size_t)(n0 + n) * 256); }, 4, ap2, ldsu);
      const int tid = opaque_tid(), lane = tid & 63, w = tid >> 6, l15 = lane & 15, quad = lane >> 4, wm = w >> 1, wn = w & 1; (void)lane; (void)wm; (void)wn; (void)l15; (void)quad;
#pragma unroll
          for (int j = 0; j < 2; j++) {
            const float bv = bg[br * 1024 + n0 + ACC_COL(64, j)];
#pragma unroll
            for (int i = 0; i < 4; i++)
#pragma unroll
              for (int e = 0; e < 4; e++) y[i][j][e] += sigmoid_f(ag[i][j][e] + bv) * ap2[i][j][e];
          }
        }
#pragma unroll
        for (int i = 0; i < 4; i++)
#pragma unroll
          for (int j = 0; j < 2; j++)
#pragma unroll
            for (int e = 0; e < 4; e++) Y[(size_t)(m0 + ACC_ROW(i, e)) * 1024 + n0 + ACC_COL(64, j)] = f2bf(y[i][j][e]);
      }
    }
    }
    }
#endif
    xcd_barrier(xbar);

#ifndef SKIP_P8
    {
    {
    const int tid = opaque_tid(), lane = tid & 63, w = tid >> 6, l15 = lane & 15, quad = lane >> 4;
    const int wm = w >> 1, wn = w & 1;
    (void)wm; (void)wn; (void)l15; (void)quad;
    {
    const int nwide = 256 * 4;
    const int total_items = nwide + (last ? 0 : 64);
    for (int it = vb; it < total_items; it += G) {
      if (it < nwide) {
        const int mi = it >> 2, nt = it & 3;
        const int mt = (mi >> 6) * 66 + 2 + (mi & 63);
        const int m0 = mt * 128, n0 = nt * 256;
        const int b = m0 / SS;
        f32x4 acc[4][8];
        gemm_wide([&](int r) { return (const u16*)(Y + (size_t)(m0 + r) * 1024); },
                  [&](int n) { return (const u16*)(W + OW_OUT + (size_t)(n0 + n) * 1024); }, 32, acc, ldsu);
        const int tid = opaque_tid(), lane = tid & 63, w = tid >> 6, l15 = lane & 15, quad = lane >> 4, wm = w >> 1, wn = w & 1; (void)lane; (void)wm; (void)wn; (void)l15; (void)quad;
        const float* g1 = modl + (size_t)b * 6144 + 2 * 1024;
        const float* xi = xrow(xin, m0) + n0;
        float* xo = xrow(xout, m0) + n0;
        asm volatile("" ::: "memory");
#pragma unroll
        for (int jh = 0; jh < 4; jh++) {
          float xv[2][4][4];
#pragma unroll
          for (int j = 0; j < 2; j++)
#pragma unroll
            for (int i = 0; i < 4; i++)
#pragma unroll
              for (int e = 0; e < 4; e++) xv[j][i][e] = xi[ACC_ROW(i, e) * 1024 + ACC_COLW(jh * 2 + j)];
#pragma unroll
          for (int j = 0; j < 2; j++) {
            const float gv = g1[n0 + ACC_COLW(jh * 2 + j)];
#pragma unroll
            for (int i = 0; i < 4; i++)
#pragma unroll
              for (int e = 0; e < 4; e++) xo[ACC_ROW(i, e) * 1024 + ACC_COLW(jh * 2 + j)] = xv[j][i][e] + gv * acc[i][jh * 2 + j][e];
          }
        }
        continue;
      }
      const int jc = it - nwide;
      const int mc = jc >> 3, nt = jc & 7;
      const int mt = (mc >> 1) * 66 + (mc & 1);
      const int m0 = mt * 128, n0 = nt * 128;
      const int b = m0 / SS, s0 = m0 - b * SS;
      const int mrow = (s0 < CC) ? 4 : b;
      f32x4 acc[4][4];
      gemm_core<128>([&](int r) { return (const u16*)(Y + (size_t)(m0 + r) * 1024); },
                     [&](int n) { return (const u16*)(W + OW_OUT + (size_t)(n0 + n) * 1024); }, 16, acc, ldsu);
      const int tid = opaque_tid(), lane = tid & 63, w = tid >> 6, l15 = lane & 15, quad = lane >> 4, wm = w >> 1, wn = w & 1; (void)lane; (void)wm; (void)wn; (void)l15; (void)quad;
      const float* g1 = modl + (size_t)mrow * 6144 + 2 * 1024;
      const float* xi = xrow(xin, m0) + n0;
      float* xo = xrow(xout, m0) + n0;
      asm volatile("" ::: "memory");
#pragma unroll
      for (int jh = 0; jh < 2; jh++) {
        float xv[2][4][4];
#pragma unroll
        for (int j = 0; j < 2; j++)
#pragma unroll
          for (int i = 0; i < 4; i++)
#pragma unroll
            for (int e = 0; e < 4; e++) xv[j][i][e] = xi[ACC_ROW(i, e) * 1024 + ACC_COL(128, jh * 2 + j)];
#pragma unroll
        for (int j = 0; j < 2; j++) {
          const float gv = g1[n0 + ACC_COL(128, jh * 2 + j)];
#pragma unroll
          for (int i = 0; i < 4; i++)
#pragma unroll
            for (int e = 0; e < 4; e++) xo[ACC_ROW(i, e) * 1024 + ACC_COL(128, jh * 2 + j)] = xv[j][i][e] + gv * acc[i][jh * 2 + j][e];
        }
      }
    }
    }
    }
    }
#endif
    xcd_barrier(xbar);

#ifndef SKIP_P9
    for (int rep_ = 0; rep_ < REP_P9; rep_++) {
    phase_modulate(xout, modl, 3, 4, H, last, vb, G);
    }
#endif
    xcd_barrier(xbar);

#ifndef SKIP_P10
    {
    for (int rep_ = 0; rep_ < REP_P10; rep_++) {
    const int tid = opaque_tid(), lane = tid & 63, w = tid >> 6, l15 = lane & 15, quad = lane >> 4;
    const int wm = w >> 1, wn = w & 1;
    (void)wm; (void)wn; (void)l15; (void)quad;
    {
      const float* cw = p.in[26] + (size_t)l * 3 * 5632;
      const float* cb = p.in[27] + (size_t)l * 5632;
      const int tpb = last ? 66 : 69;
      const int total = NB * tpb * 22;
      for (int it = vb; it < total; it += G) {
        const int MT = NB * tpb;
        const int g8 = it / (8 * 22);
        const int rem = it - g8 * (8 * 22);
        const int gsz = (MT - g8 * 8) < 8 ? (MT - g8 * 8) : 8;
        const int nt = rem / gsz;
        const int mt = g8 * 8 + (rem - nt * gsz);
        const int b = mt / tpb;
        int ti = mt - b * tpb;
        int seg_lo, seg_hi;
        if (last) { seg_lo = CC; seg_hi = SS; }
        else if (ti < 3) { seg_lo = 0; seg_hi = CC; }
        else { ti -= 3; seg_lo = CC; seg_hi = SS; }
        const int sfirst = seg_lo + 126 * ti - 1;
        const int c0 = nt * 128;
        f32x4 acc[4][8];
        gemm_wide([&](int r) { int s = sfirst + r; return (s >= seg_lo && s < seg_hi) ? (const u16*)(H + (size_t)(b * SS + s) * DD) : (const u16*)(p.ws + WS_ZROW); },
                  [&](int n) { int ch = ((n >> 7) ? FF : 0) + c0 + (n & 127); return (const u16*)(W + OW_UP + (size_t)ch * 1024); }, 32, acc, ldsu);
      const int tid = opaque_tid(), lane = tid & 63, w = tid >> 6, l15 = lane & 15, quad = lane >> 4, wm = w >> 1, wn = w & 1; (void)lane; (void)wm; (void)wn; (void)l15; (void)quad;
#pragma unroll
        for (int pss = 0; pss < 2; pss++) {
        if (pss) __syncthreads();
#pragma unroll
        for (int i = 0; i < 4; i++)
#pragma unroll
          for (int j = 0; j < 4; j++)
            *(f32x4*)(ldsf + ACC_COL(128, j) * 132 + wm * 64 + i * 16 + quad * 4) = acc[i][pss * 4 + j];
        __syncthreads();
        const int cc = tid & 63, rg = tid >> 6;
        const int ch = c0 + pss * 64 + cc;
        const float wa0 = cw[ch], wa1 = cw[5632 + ch], wa2 = cw[2 * 5632 + ch], ba = cb[ch];
        const float wg0 = cw[FF + ch], wg1 = cw[5632 + FF + ch], wg2 = cw[2 * 5632 + FF + ch], bgv = cb[FF + ch];
        u16* actb = ACT + (size_t)(b * SS) * FF + ch;
        const float* sa = ldsf + cc * 132;
        const float* sg = ldsf + (64 + cc) * 132;
#pragma unroll 4
        for (int i = 0; i < 8; i++) {
          const int r0 = (rg + 4 * i) * 4;
          const f32x4 a4 = *(const f32x4*)(sa + r0);
          const f32x4 g4 = *(const f32x4*)(sg + r0);
          const float am = (r0 > 0) ? sa[r0 - 1] : 0.f, ap = sa[r0 + 4];
          const float gm = (r0 > 0) ? sg[r0 - 1] : 0.f, gp = sg[r0 + 4];
          float av[4], gv[4];
          av[0] = wa0 * am + wa1 * a4[0] + wa2 * a4[1] + ba;
          av[1] = wa0 * a4[0] + wa1 * a4[1] + wa2 * a4[2] + ba;
          av[2] = wa0 * a4[1] + wa1 * a4[2] + wa2 * a4[3] + ba;
          av[3] = wa0 * a4[2] + wa1 * a4[3] + wa2 * ap + ba;
          gv[0] = wg0 * gm + wg1 * g4[0] + wg2 * g4[1] + bgv;
          gv[1] = wg0 * g4[0] + wg1 * g4[1] + wg2 * g4[2] + bgv;
          gv[2] = wg0 * g4[1] + wg1 * g4[2] + wg2 * g4[3] + bgv;
          gv[3] = wg0 * g4[2] + wg1 * g4[3] + wg2 * gp + bgv;
#pragma unroll
          for (int e = 0; e < 4; e++) {
            const int r = r0 + e;
            const int s = sfirst + r;
            if (r >= 1 && r <= 126 && s >= seg_lo && s < seg_hi) actb[(size_t)s * FF] = f2bf(silu_f(gv[e]) * av[e]);
          }
        }
        }
      }
    }
    }
    }
#endif
    xcd_barrier(xbar);

#ifndef SKIP_P11
    {
    {
    const int tid = opaque_tid(), lane = tid & 63, w = tid >> 6, l15 = lane & 15, quad = lane >> 4;
    const int wm = w >> 1, wn = w & 1;
    (void)wm; (void)wn; (void)l15; (void)quad;
    {
    const int nwide = 256 * 4;
    const int total_items = nwide + (last ? 0 : 64);
    for (int it = vb; it < total_items; it += G) {
      if (it < nwide) {
        const int mi = it >> 2, nt = it & 3;
        const int mt = (mi >> 6) * 66 + 2 + (mi & 63);
        const int m0 = mt * 128, n0 = nt * 256;
        const int b = m0 / SS;
        f32x4 acc[4][8];
        gemm_wide([&](int r) { return (const u16*)(ACT + (size_t)(m0 + r) * FF); },
                  [&](int n) { return (const u16*)(W + OW_DOWN + (size_t)(n0 + n) * FF); }, 88, acc, ldsu);
        const int tid = opaque_tid(), lane = tid & 63, w = tid >> 6, l15 = lane & 15, quad = lane >> 4, wm = w >> 1, wn = w & 1; (void)lane; (void)wm; (void)wn; (void)l15; (void)quad;
        const float* g2 = modl + (size_t)b * 6144 + 5 * 1024;

        float* xo = xrow(xout, m0) + n0;
        asm volatile("" ::: "memory");
#pragma unroll
        for (int jh = 0; jh < 4; jh++) {
          float xv[2][4][4];
#pragma unroll
          for (int j = 0; j < 2; j++)
#pragma unroll
            for (int i = 0; i < 4; i++)
#pragma unroll
              for (int e = 0; e < 4; e++) xv[j][i][e] = xo[ACC_ROW(i, e) * 1024 + ACC_COLW(jh * 2 + j)];
#pragma unroll
          for (int j = 0; j < 2; j++) {
            const float gv = g2[n0 + ACC_COLW(jh * 2 + j)];
#pragma unroll
            for (int i = 0; i < 4; i++)
#pragma unroll
              for (int e = 0; e < 4; e++) xo[ACC_ROW(i, e) * 1024 + ACC_COLW(jh * 2 + j)] = xv[j][i][e] + gv * acc[i][jh * 2 + j][e];
          }
        }
        continue;
      }
      const int jc = it - nwide;
      const int mc = jc >> 3, nt = jc & 7;
      const int mt = (mc >> 1) * 66 + (mc & 1);
      const int m0 = mt * 128, n0 = nt * 128;
      const int b = m0 / SS, s0 = m0 - b * SS;
      const int mrow = (s0 < CC) ? 4 : b;
      f32x4 acc[4][4];
      gemm_core<128>([&](int r) { return (const u16*)(ACT + (size_t)(m0 + r) * FF); },
                     [&](int n) { return (const u16*)(W + OW_DOWN + (size_t)(n0 + n) * FF); }, 44, acc, ldsu);
      const int tid = opaque_tid(), lane = tid & 63, w = tid >> 6, l15 = lane & 15, quad = lane >> 4, wm = w >> 1, wn = w & 1; (void)lane; (void)wm; (void)wn; (void)l15; (void)quad;
      const float* g2 = modl + (size_t)mrow * 6144 + 5 * 1024;
      float* xo = xrow(xout, m0) + n0;
      asm volatile("" ::: "memory");
#pragma unroll
      for (int jh = 0; jh < 2; jh++) {
        float xv[2][4][4];
#pragma unroll
        for (int j = 0; j < 2; j++)
#pragma unroll
          for (int i = 0; i < 4; i++)
#pragma unroll
            for (int e = 0; e < 4; e++) xv[j][i][e] = xo[ACC_ROW(i, e) * 1024 + ACC_COL(128, jh * 2 + j)];
#pragma unroll
        for (int j = 0; j < 2; j++) {
          const float gv = g2[n0 + ACC_COL(128, jh * 2 + j)];
#pragma unroll
          for (int i = 0; i < 4; i++)
#pragma unroll
            for (int e = 0; e < 4; e++) xo[ACC_ROW(i, e) * 1024 + ACC_COL(128, jh * 2 + j)] = xv[j][i][e] + gv * acc[i][jh * 2 + j][e];
        }
      }
    }
    }
    }
    }
#endif
  }
}

extern "C" void kernel_launch(void* const* d_in, const int* in_sizes, int n_in, void* d_out, int out_size,
                              void* d_ws, size_t ws_size, hipStream_t stream) {
  static int grid_blocks = 0;
  if (!grid_blocks) {
    int dev = 0, cus = 0, per_cu = 0;
    (void)hipGetDevice(&dev);
    (void)hipDeviceGetAttribute(&cus, hipDeviceAttributeMultiprocessorCount, dev);
    (void)hipOccupancyMaxActiveBlocksPerMultiprocessor(&per_cu, fwd_megakernel, 256, 0);
    if (per_cu > 2) per_cu = 2;
    if (per_cu < 1) per_cu = 1;
    grid_blocks = cus * per_cu;
    if (ws_size < WS_END) fprintf(stderr, "workspace too small: %zu < %zu\n", ws_size, (size_t)WS_END);
  }
  Params p{};
  for (int i = 0; i < 29; i++) p.in[i] = (const float*)d_in[i];
  p.out = (float*)d_out;
  p.ws = (char*)d_ws;
  p.pad = 0;
  (void)hipMemsetAsync((char*)d_ws + WS_BAR, 0, 3456 * 4, stream);
  void* args[] = {&p};
  hipError_t e = hipLaunchCooperativeKernel((void*)fwd_megakernel, dim3(grid_blocks), dim3(256), args, 0, stream);
  if (e != hipSuccess) fprintf(stderr, "cooperative launch failed: %s (grid %d)\n", hipGetErrorString(e), grid_blocks);
}
```

```cpp
#include <hip/hip_runtime.h>
#include <hip/hip_bf16.h>
#include <hip/hip_cooperative_groups.h>
#include <cstdio>
#include <cstdint>
namespace cg = cooperative_groups;

typedef unsigned short u16;
using bf16x8 = __attribute__((ext_vector_type(8))) short;
using f32x4 = __attribute__((ext_vector_type(4))) float;
using u32x4 = __attribute__((ext_vector_type(4))) unsigned;

#define DEV __device__ __forceinline__
#ifndef REP_P0
#define REP_P0 1
#endif
#ifndef REP_SYNC
#define REP_SYNC 0
#endif
#ifndef REP_P3
#define REP_P3 1
#endif
#ifndef REP_P8
#define REP_P8 1
#endif
#ifndef REP_P11
#define REP_P11 1
#endif
#ifndef REP_P1
#define REP_P1 1
#endif
#ifndef REP_P2
#define REP_P2 1
#endif
#ifndef REP_P4
#define REP_P4 1
#endif
#ifndef REP_P6
#define REP_P6 1
#endif
#ifndef REP_P7
#define REP_P7 1
#endif
#ifndef REP_P9
#define REP_P9 1
#endif
#ifndef REP_P10
#define REP_P10 1
#endif

constexpr int NB = 4, TT = 8192, CC = 256, SS = 8448, MM = NB * SS, DD = 1024;
constexpr int ZW = 2304, FF = 2816;
constexpr float EPS = 1e-6f;
constexpr float LOG2E = 1.4426950408889634f;

constexpr size_t OW_IN = 0;
constexpr size_t OW_GATE = OW_IN + (size_t)2304 * 1024;
constexpr size_t OW_BRANCH = OW_GATE + (size_t)4 * 1024 * 1024;
constexpr size_t OW_OUT = OW_BRANCH + (size_t)4 * 1024 * 256;
constexpr size_t OW_UP = OW_OUT + (size_t)1024 * 1024;
constexpr size_t OW_DOWN = OW_UP + (size_t)5632 * 1024;
constexpr size_t OW_UQ = OW_DOWN + (size_t)1024 * 2816;
constexpr size_t OW_UKV = OW_UQ + (size_t)384 * 256;
constexpr size_t OW_SG = OW_UKV + (size_t)512 * 192;
constexpr size_t WL = OW_SG + (size_t)4 * 128 * 128;

constexpr size_t WS_W = 0;
constexpr size_t WS_MOD = WS_W + 2 * WL * 2;
constexpr size_t WS_R16 = WS_MOD + (size_t)2 * 5 * 6144 * 4;
constexpr size_t WS_R8 = WS_R16 + (size_t)128 * 16 * 8;
constexpr size_t WS_CX = WS_R8 + (size_t)128 * 8 * 8;
constexpr size_t WS_H = WS_CX + (size_t)NB * CC * DD * 4;
constexpr size_t WS_Z = WS_H + (size_t)MM * DD * 2;
constexpr size_t WS_QKV = WS_Z + (size_t)MM * ZW * 2;
constexpr size_t WS_ZROW = WS_QKV + (size_t)MM * FF * 2;
constexpr size_t WS_BAR = WS_ZROW + 4096;
constexpr size_t WS_END = WS_BAR + 3456 * 4;

constexpr size_t Q_NA = 0;
constexpr size_t K_NA = (size_t)MM * 256;
constexpr size_t V_NA = (size_t)MM * 512;
constexpr size_t Q_MLA = (size_t)MM * 768;
constexpr size_t K_MLA = (size_t)MM * 1152;
constexpr size_t V_MLA = (size_t)MM * 1536;
constexpr size_t Q_GQA = (size_t)MM * 1792;
constexpr size_t K_GQA = (size_t)MM * 2048;
constexpr size_t V_GQA = (size_t)MM * 2176;
constexpr size_t SG_U = (size_t)MM * 2304;
constexpr size_t SG_VT = (size_t)MM * 2560;

constexpr int SMEM_BYTES = 67584;

struct Params {
  const float* in[29];
  float* out;
  char* ws;
  long pad;
};

DEV float bf2f(u16 h) { return __uint_as_float(((unsigned)h) << 16); }
DEV u16 f2bf(float f) {
  __bf16 r = (__bf16)f;
  return __builtin_bit_cast(u16, r);
}
typedef __bf16 bf16x2_t __attribute__((ext_vector_type(2)));
typedef float f32x2_t __attribute__((ext_vector_type(2)));
DEV unsigned pack2(float a, float b) {
  f32x2_t v = {a, b};
  bf16x2_t r = __builtin_convertvector(v, bf16x2_t);
  return __builtin_bit_cast(unsigned, r);
}
DEV void load8(const u16* p, float (&f)[8]) {
  uint4 v = *(const uint4*)p;
  f[0] = __uint_as_float(v.x << 16); f[1] = __uint_as_float(v.x & 0xffff0000u);
  f[2] = __uint_as_float(v.y << 16); f[3] = __uint_as_float(v.y & 0xffff0000u);
  f[4] = __uint_as_float(v.z << 16); f[5] = __uint_as_float(v.z & 0xffff0000u);
  f[6] = __uint_as_float(v.w << 16); f[7] = __uint_as_float(v.w & 0xffff0000u);
}
DEV void store8(u16* p, const float (&f)[8]) {
  uint4 v;
  v.x = pack2(f[0], f[1]); v.y = pack2(f[2], f[3]); v.z = pack2(f[4], f[5]); v.w = pack2(f[6], f[7]);
  *(uint4*)p = v;
}
DEV float silu_f(float x) { return x * __builtin_amdgcn_rcpf(1.f + __expf(-x)); }
DEV float sigmoid_f(float x) { return __builtin_amdgcn_rcpf(1.f + __expf(-x)); }
DEV float gelu_f(float x) {
  float y = 0.7978845608028654f * (x + 0.044715f * x * x * x);
  float t = 1.f - 2.f * __builtin_amdgcn_rcpf(__expf(2.f * y) + 1.f);
  return 0.5f * x * (1.f + t);
}
DEV int perm32(int s) {
  int k = s & 31;
  int pos = ((k >> 2) & 3) * 8 + (k >> 4) * 4 + (k & 3);
  return (s & ~31) | pos;
}
DEV int opaque_tid() { int t = threadIdx.x; asm volatile("" : "+v"(t)); return t; }
DEV float shfl_xor_f(float v, int mask) {
  int ln = __builtin_amdgcn_mbcnt_hi(~0u, __builtin_amdgcn_mbcnt_lo(~0u, 0u));
  asm volatile("" : "+v"(ln));
  return __int_as_float(__builtin_amdgcn_ds_bpermute((ln ^ mask) << 2, __float_as_int(v)));
}
DEV int clampi(int v, int lo, int hi) { return v < lo ? lo : (v > hi ? hi : v); }

struct XMap { float* lat; float* ctx; };
DEV float* xrow(const XMap& xm, int m) {
  int b = m / SS;
  int s = m - b * SS;
  return s < CC ? xm.ctx + ((size_t)(b * CC + s)) * DD : xm.lat + ((size_t)(b * TT + s - CC)) * DD;
}

template <int BN, class AF, class BF>
DEV void gemm_core(AF arow, BF brow, int nk, f32x4 (&acc)[4][BN / 32], u16* lds) {
  constexpr int NF = BN / 32;
  constexpr int STAGE = (128 + BN) * 64;
  constexpr int NBI = (BN * 8) / 256;
  static_assert((BN * 8) % 256 == 0, "BN");
  const int tid = opaque_tid(), lane = tid & 63, w = tid >> 6, l15 = lane & 15, quad = lane >> 4;
  const int wm = w >> 1, wn = w & 1;
  const u16* ap[4];
  const u16* bp[NBI];
#pragma unroll
  for (int i = 0; i < 4; i++) {
    int c = tid + i * 256;
    ap[i] = arow(c >> 3) + (c & 7) * 8;
  }
#pragma unroll
  for (int i = 0; i < NBI; i++) {
    int c = tid + i * 256;
    bp[i] = brow(c >> 3) + (c & 7) * 8;
  }
  const int srow = tid >> 3;
  const int soff = srow * 64 + (((tid & 7) ^ ((srow >> 1) & 7)) * 8);
  const int swz = (l15 >> 1) & 7;
  u32x4 r0a[4], r0b[NBI], r1a[4], r1b[NBI];
#pragma unroll
  for (int i = 0; i < 4; i++)
#pragma unroll
    for (int j = 0; j < NF; j++) acc[i][j] = f32x4{0.f, 0.f, 0.f, 0.f};

#define GLOAD(RA, RB, KT)                                                              \
  {                                                                                    \
    _Pragma("unroll") for (int i = 0; i < 4; i++) RA[i] = *(const u32x4*)(ap[i] + (KT) * 64);   \
    _Pragma("unroll") for (int i = 0; i < NBI; i++) RB[i] = *(const u32x4*)(bp[i] + (KT) * 64); \
  }
#define SSTORE(RA, RB, ST)                                                             \
  {                                                                                    \
    u16* A_ = lds + (ST) * STAGE;                                                      \
    u16* B_ = A_ + 128 * 64;                                                           \
    _Pragma("unroll") for (int i = 0; i < 4; i++) *(u32x4*)(A_ + soff + i * 32 * 64) = RA[i];   \
    _Pragma("unroll") for (int i = 0; i < NBI; i++) *(u32x4*)(B_ + soff + i * 32 * 64) = RB[i]; \
  }
#define LFRAGS(ST)                                                                     \
    const u16* A_ = lds + (ST) * STAGE;                                                \
    const u16* B_ = A_ + 128 * 64;                                                     \
    bf16x8 af[2][4], bfr[2][NF];                                                       \
    _Pragma("unroll") for (int ks = 0; ks < 2; ks++) {                                 \
      const int co = (((ks * 4 + quad) ^ swz) * 8);                                    \
      _Pragma("unroll") for (int i = 0; i < 4; i++) af[ks][i] = *(const bf16x8*)(A_ + (wm * 64 + i * 16 + l15) * 64 + co);          \
      _Pragma("unroll") for (int j = 0; j < NF; j++) bfr[ks][j] = *(const bf16x8*)(B_ + (wn * (BN / 2) + j * 16 + l15) * 64 + co);  \
    }
#define MFMAS(KS)                                                                      \
    _Pragma("unroll") for (int i = 0; i < 4; i++)                                      \
      _Pragma("unroll") for (int j = 0; j < NF; j++)                                   \
        acc[i][j] = __builtin_amdgcn_mfma_f32_16x16x32_bf16(af[KS][i], bfr[KS][j], acc[i][j], 0, 0, 0);

  __syncthreads();
  GLOAD(r0a, r0b, 0);
  if (nk > 1) GLOAD(r1a, r1b, 1);
  SSTORE(r0a, r0b, 0);
  __syncthreads();
  for (int kt = 0; kt < nk; kt += 2) {
    {
      if (kt + 2 < nk) GLOAD(r0a, r0b, kt + 2);
      LFRAGS(0);
      __builtin_amdgcn_sched_barrier(0);
      __builtin_amdgcn_s_setprio(1);
      MFMAS(0);
      __builtin_amdgcn_sched_barrier(0);
      if (kt + 1 < nk) SSTORE(r1a, r1b, 1);
      __builtin_amdgcn_sched_barrier(0);
      MFMAS(1);
      __builtin_amdgcn_s_setprio(0);
      __syncthreads();
    }
    if (kt + 1 >= nk) break;
    {
      if (kt + 3 < nk) GLOAD(r1a, r1b, kt + 3);
      LFRAGS(1);
      __builtin_amdgcn_sched_barrier(0);
      __builtin_amdgcn_s_setprio(1);
      MFMAS(0);
      __builtin_amdgcn_sched_barrier(0);
      if (kt + 2 < nk) SSTORE(r0a, r0b, 0);
      __builtin_amdgcn_sched_barrier(0);
      MFMAS(1);
      __builtin_amdgcn_s_setprio(0);
      __syncthreads();
    }
  }
#undef GLOAD
#undef SSTORE
#undef LFRAGS
#undef MFMAS
}

template <int BN, class AF1, class BF1, class AF2, class BF2>
DEV void gemm_dual(AF1 arow1, BF1 brow1, int nk1, f32x4 (&acc1)[4][BN / 32], AF2 arow2, BF2 brow2, int nk2,
                   f32x4 (&acc2)[4][BN / 32], u16* lds) {
  constexpr int NF = BN / 32;
  constexpr int STAGE = (128 + BN) * 64;
  constexpr int NBI = (BN * 8) / 256;
  const int tid = opaque_tid(), lane = tid & 63, w = tid >> 6, l15 = lane & 15, quad = lane >> 4;
  const int wm = w >> 1, wn = w & 1;
  const int nk = nk1 + nk2;
  const u16* ap1[4]; const u16* bp1[NBI]; const u16* ap2[4]; const u16* bp2[NBI];
#pragma unroll
  for (int i = 0; i < 4; i++) {
    int c = tid + i * 256;
    ap1[i] = arow1(c >> 3) + (c & 7) * 8;
    ap2[i] = arow2(c >> 3) + (c & 7) * 8 - (size_t)nk1 * 64;
  }
#pragma unroll
  for (int i = 0; i < NBI; i++) {
    int c = tid + i * 256;
    bp1[i] = brow1(c >> 3) + (c & 7) * 8;
    bp2[i] = brow2(c >> 3) + (c & 7) * 8 - (size_t)nk1 * 64;
  }
  const int srow = tid >> 3;
  const int soff = srow * 64 + (((tid & 7) ^ ((srow >> 1) & 7)) * 8);
  const int swz = (l15 >> 1) & 7;
  u32x4 r0a[4], r0b[NBI], r1a[4], r1b[NBI];
#pragma unroll
  for (int i = 0; i < 4; i++)
#pragma unroll
    for (int j = 0; j < NF; j++) { acc1[i][j] = f32x4{0.f, 0.f, 0.f, 0.f}; acc2[i][j] = f32x4{0.f, 0.f, 0.f, 0.f}; }

#define GLOAD(RA, RB, KT)                                                              \
  {                                                                                    \
    const bool s2_ = (KT) >= nk1;                                                      \
    _Pragma("unroll") for (int i = 0; i < 4; i++) RA[i] = *(const u32x4*)((s2_ ? ap2[i] : ap1[i]) + (KT) * 64);   \
    _Pragma("unroll") for (int i = 0; i < NBI; i++) RB[i] = *(const u32x4*)((s2_ ? bp2[i] : bp1[i]) + (KT) * 64); \
  }
#define SSTORE(RA, RB, ST)                                                             \
  {                                                                                    \
    u16* A_ = lds + (ST) * STAGE;                                                      \
    u16* B_ = A_ + 128 * 64;                                                           \
    _Pragma("unroll") for (int i = 0; i < 4; i++) *(u32x4*)(A_ + soff + i * 32 * 64) = RA[i];   \
    _Pragma("unroll") for (int i = 0; i < NBI; i++) *(u32x4*)(B_ + soff + i * 32 * 64) = RB[i]; \
  }
#define LFRAGS(ST)                                                                     \
    const u16* A_ = lds + (ST) * STAGE;                                                \
    const u16* B_ = A_ + 128 * 64;                                                     \
    bf16x8 af[2][4], bfr[2][NF];                                                       \
    _Pragma("unroll") for (int ks = 0; ks < 2; ks++) {                                 \
      const int co = (((ks * 4 + quad) ^ swz) * 8);                                    \
      _Pragma("unroll") for (int i = 0; i < 4; i++) af[ks][i] = *(const bf16x8*)(A_ + (wm * 64 + i * 16 + l15) * 64 + co);          \
      _Pragma("unroll") for (int j = 0; j < NF; j++) bfr[ks][j] = *(const bf16x8*)(B_ + (wn * (BN / 2) + j * 16 + l15) * 64 + co);  \
    }
#define MFMAS(ACC, KS)                                                                 \
    _Pragma("unroll") for (int i = 0; i < 4; i++)                                      \
      _Pragma("unroll") for (int j = 0; j < NF; j++)                                   \
        ACC[i][j] = __builtin_amdgcn_mfma_f32_16x16x32_bf16(af[KS][i], bfr[KS][j], ACC[i][j], 0, 0, 0);
#define STEP_PAIR(ACC)                                                                 \
    {                                                                                  \
      if (kt + 2 < nk) GLOAD(r0a, r0b, kt + 2);                                        \
      LFRAGS(0);                                                                       \
      __builtin_amdgcn_sched_barrier(0);                                               \
      MFMAS(ACC, 0);                                                                   \
      __builtin_amdgcn_sched_barrier(0);                                               \
      SSTORE(r1a, r1b, 1);                                                             \
      __builtin_amdgcn_sched_barrier(0);                                               \
      MFMAS(ACC, 1);                                                                   \
      __syncthreads();                                                                 \
    }                                                                                  \
    {                                                                                  \
      if (kt + 3 < nk) GLOAD(r1a, r1b, kt + 3);                                        \
      LFRAGS(1);                                                                       \
      __builtin_amdgcn_sched_barrier(0);                                               \
      MFMAS(ACC, 0);                                                                   \
      __builtin_amdgcn_sched_barrier(0);                                               \
      if (kt + 2 < nk) SSTORE(r0a, r0b, 0);                                            \
      __builtin_amdgcn_sched_barrier(0);                                               \
      MFMAS(ACC, 1);                                                                   \
      __syncthreads();                                                                 \
    }

  __syncthreads();
  GLOAD(r0a, r0b, 0);
  GLOAD(r1a, r1b, 1);
  SSTORE(r0a, r0b, 0);
  __syncthreads();
  for (int kt = 0; kt < nk1; kt += 2) { STEP_PAIR(acc1) }
  for (int kt = nk1; kt < nk; kt += 2) { STEP_PAIR(acc2) }
#undef GLOAD
#undef SSTORE
#undef LFRAGS
#undef MFMAS
#undef STEP_PAIR
}

template <class AF, class BF>
DEV void gemm_wide(AF arow, BF brow, int nk, f32x4 (&acc)[4][8], u16* lds) {
  constexpr int STAGE = (128 + 256) * 32;
  const int tid = opaque_tid(), lane = tid & 63, w = tid >> 6, l15 = lane & 15, quad = lane >> 4;
  const int wm = w >> 1, wn = w & 1;
  const u16* ap[2];
  const u16* bp[4];
#pragma unroll
  for (int i = 0; i < 2; i++) {
    int c = tid + i * 256;
    ap[i] = arow(c >> 2) + (c & 3) * 8;
  }
#pragma unroll
  for (int i = 0; i < 4; i++) {
    int c = tid + i * 256;
    bp[i] = brow(c >> 2) + (c & 3) * 8;
  }
  u32x4 ra[2], rb[4];
#pragma unroll
  for (int i = 0; i < 4; i++)
#pragma unroll
    for (int j = 0; j < 8; j++) acc[i][j] = f32x4{0.f, 0.f, 0.f, 0.f};
  __syncthreads();
#pragma unroll
  for (int i = 0; i < 2; i++) ra[i] = *(const u32x4*)(ap[i]);
#pragma unroll
  for (int i = 0; i < 4; i++) rb[i] = *(const u32x4*)(bp[i]);
  {
    u16* A_ = lds;
    u16* B_ = A_ + 128 * 32;
#pragma unroll
    for (int i = 0; i < 2; i++) *(u32x4*)(A_ + (tid + i * 256) * 8) = ra[i];
#pragma unroll
    for (int i = 0; i < 4; i++) *(u32x4*)(B_ + (tid + i * 256) * 8) = rb[i];
  }
  __syncthreads();
  for (int kt = 0; kt < nk; kt++) {
    const bool more = (kt + 1 < nk);
    if (more) {
#pragma unroll
      for (int i = 0; i < 2; i++) ra[i] = *(const u32x4*)(ap[i] + (kt + 1) * 32);
#pragma unroll
      for (int i = 0; i < 4; i++) rb[i] = *(const u32x4*)(bp[i] + (kt + 1) * 32);
    }
    const u16* A_ = lds + (kt & 1) * STAGE;
    const u16* B_ = A_ + 128 * 32;
    bf16x8 af[4], bfr[8];
#pragma unroll
    for (int i = 0; i < 4; i++) af[i] = *(const bf16x8*)(A_ + (wm * 64 + i * 16 + l15) * 32 + quad * 8);
#pragma unroll
    for (int j = 0; j < 8; j++) bfr[j] = *(const bf16x8*)(B_ + (wn * 128 + j * 16 + l15) * 32 + quad * 8);
    __builtin_amdgcn_sched_barrier(0);
    __builtin_amdgcn_s_setprio(1);
#pragma unroll
    for (int j = 0; j < 4; j++)
#pragma unroll
      for (int i = 0; i < 4; i++) acc[i][j] = __builtin_amdgcn_mfma_f32_16x16x32_bf16(af[i], bfr[j], acc[i][j], 0, 0, 0);
    __builtin_amdgcn_sched_barrier(0);
    if (more) {
      u16* A2 = lds + ((kt + 1) & 1) * STAGE;
      u16* B2 = A2 + 128 * 32;
#pragma unroll
      for (int i = 0; i < 2; i++) *(u32x4*)(A2 + (tid + i * 256) * 8) = ra[i];
#pragma unroll
      for (int i = 0; i < 4; i++) *(u32x4*)(B2 + (tid + i * 256) * 8) = rb[i];
    }
    __builtin_amdgcn_sched_barrier(0);
#pragma unroll
    for (int j = 4; j < 8; j++)
#pragma unroll
      for (int i = 0; i < 4; i++) acc[i][j] = __builtin_amdgcn_mfma_f32_16x16x32_bf16(af[i], bfr[j], acc[i][j], 0, 0, 0);
    __builtin_amdgcn_s_setprio(0);
    __syncthreads();
  }
}
#define ACC_COLW(j) (wn * 128 + (j) * 16 + l15)

#define ACC_ROW(i, e) (wm * 64 + (i) * 16 + quad * 4 + (e))
#define ACC_COL(BN, j) (wn * ((BN) / 2) + (j) * 16 + l15)

template <int BN>
DEV void acc_to_lds(f32x4 (&acc)[4][BN / 32], float* st) {
  const int tid = opaque_tid(), lane = tid & 63, w = tid >> 6, l15 = lane & 15, quad = lane >> 4;
  const int wm = w >> 1, wn = w & 1;
#pragma unroll
  for (int i = 0; i < 4; i++)
#pragma unroll
    for (int j = 0; j < BN / 32; j++)
#pragma unroll
      for (int e = 0; e < 4; e++) st[ACC_ROW(i, e) * (BN + 1) + ACC_COL(BN, j)] = acc[i][j][e];
}

template <int DQ, bool NA>
DEV void attn_item(const u16* __restrict__ Qb, const u16* __restrict__ Kb, const u16* __restrict__ Vt, int q0, int t0,
                   int n0, int t1, int n1, float sc2, float mref2, u16* __restrict__ Op, int r0, const float* __restrict__ rpbh,
                   u16* lds, float* rpb_lds) {
  constexpr int NDC = DQ / 32;
  constexpr int KT = 64 * DQ, VT = 64 * 64, STAGE = KT + VT;
#define KOFF(row, kc) (((kc) < 8) ? ((row) * 64 + ((((kc) ^ (((row) >> 1) & 7))) * 8)) : (4096 + (row) * 32 + ((kc) - 8) * 8))
#define VOFF(dv, kc) ((dv) * 64 + ((((kc) ^ (((dv) >> 1) & 7))) * 8))
  constexpr int CPR = DQ / 8;
  constexpr int NKI = (64 * CPR) / 256;
  const int tid = opaque_tid(), lane = tid & 63, w = tid >> 6, l15 = lane & 15, quad = lane >> 4;
  __syncthreads();
  if (NA) {
    for (int i = tid; i < 465; i += 256) rpb_lds[i] = rpbh[i] * (LOG2E / sc2);
  }
  bf16x8 qf[2][NDC];
#pragma unroll
  for (int qg = 0; qg < 2; qg++)
#pragma unroll
    for (int dc = 0; dc < NDC; dc++)
      qf[qg][dc] = *(const bf16x8*)(Qb + (size_t)(q0 + w * 32 + qg * 16 + l15) * DQ + dc * 32 + quad * 8);
  u32x4 rk[NKI], rv[2];
  const int nt = n0 + n1;
  f32x4 o[4][2];
#pragma unroll
  for (int dg = 0; dg < 4; dg++)
#pragma unroll
    for (int qg = 0; qg < 2; qg++) o[dg][qg] = f32x4{0.f, 0.f, 0.f, 0.f};
  float lrun[2] = {0.f, 0.f};
  f32x4 zero4 = f32x4{0.f, 0.f, 0.f, 0.f};
  asm volatile("" : "+v"(zero4));

  {
    const int t = (0 < n0) ? t0 : t1;
#pragma unroll
    for (int i = 0; i < NKI; i++) {
      int c = tid + i * 256;
      int row = c / CPR, kc = c % CPR;
      rk[i] = *(const u32x4*)(Kb + (size_t)t * (64 * DQ) + (unsigned)(row * DQ + kc * 8));
    }
#pragma unroll
    for (int i = 0; i < 2; i++) {
      int c = tid + i * 256;
      int dv = c >> 3, kc = c & 7;
      rv[i] = *(const u32x4*)(Vt + (size_t)t * 64 + (unsigned)(dv * SS + kc * 8));
    }
    u16* Ks = lds;
    u16* Vs = Ks + KT;
#pragma unroll
    for (int i = 0; i < NKI; i++) {
      int c = tid + i * 256;
      int row = c / CPR, kc = c % CPR;
      *(u32x4*)(Ks + KOFF(row, kc)) = rk[i];
    }
#pragma unroll
    for (int i = 0; i < 2; i++) {
      int c = tid + i * 256;
      int dv = c >> 3, kc = c & 7;
      *(u32x4*)(Vs + VOFF(dv, kc)) = rv[i];
    }
  }
  __syncthreads();
  for (int it = 0; it < nt; it++) {
    const bool more = (it + 1 < nt);
    if (more) {
      const int t = (it + 1 < n0) ? (t0 + it + 1) : (t1 + it + 1 - n0);
#pragma unroll
      for (int i = 0; i < NKI; i++) {
        int c = tid + i * 256;
        int row = c / CPR, kc = c % CPR;
        rk[i] = *(const u32x4*)(Kb + (size_t)t * (64 * DQ) + (unsigned)(row * DQ + kc * 8));
      }
#pragma unroll
      for (int i = 0; i < 2; i++) {
        int c = tid + i * 256;
        int dv = c >> 3, kc = c & 7;
        rv[i] = *(const u32x4*)(Vt + (size_t)t * 64 + (unsigned)(dv * SS + kc * 8));
      }
    }
    const u16* Ks = lds + (it & 1) * STAGE;
    const u16* Vs = Ks + KT;
    f32x4 s[4][2];
    {
      bf16x8 kf[NDC][4];
#pragma unroll
      for (int dc = 0; dc < NDC; dc++)
#pragma unroll
        for (int kg = 0; kg < 4; kg++) kf[dc][kg] = *(const bf16x8*)(Ks + KOFF(kg * 16 + l15, dc * 4 + quad));
#pragma unroll
      for (int kg = 0; kg < 4; kg++)
#pragma unroll
        for (int qg = 0; qg < 2; qg++) s[kg][qg] = __builtin_amdgcn_mfma_f32_16x16x32_bf16(kf[0][kg], qf[qg][0], zero4, 0, 0, 0);
#pragma unroll
      for (int dc = 1; dc < NDC; dc++)
#pragma unroll
        for (int kg = 0; kg < 4; kg++)
#pragma unroll
          for (int qg = 0; qg < 2; qg++) s[kg][qg] = __builtin_amdgcn_mfma_f32_16x16x32_bf16(kf[dc][kg], qf[qg][dc], s[kg][qg], 0, 0, 0);
    }
    bf16x8 vf[2][4];
#pragma unroll
    for (int t2 = 0; t2 < 2; t2++)
#pragma unroll
      for (int dg = 0; dg < 4; dg++) vf[t2][dg] = *(const bf16x8*)(Vs + VOFF(dg * 16 + l15, t2 * 4 + quad));
    if (NA) {
      const bool band = (it >= n0);
      if (band) {
        const int kr = t1 + (it - n0) - 4;
        const int r = r0 + (w >> 1);
        const int rs = clampi(r - 4, 0, 120);
        const bool rowok = (kr >= rs) && (kr < rs + 8);
#pragma unroll
        for (int qg = 0; qg < 2; qg++) {
          const int qc = (w & 1) * 32 + qg * 16 + l15;
          const int cs = clampi(qc - 8, 0, 48);
#pragma unroll
          for (int kg = 0; kg < 4; kg++)
#pragma unroll
            for (int e = 0; e < 4; e++) {
              const int kc = kg * 16 + quad * 4 + e;
              const bool ok = rowok && (kc >= cs) && (kc < cs + 16);
              int bi = (kr - r + 7) * 31 + (kc - qc + 15);
              bi = ok ? bi : 0;
              s[kg][qg][e] = ok ? (s[kg][qg][e] + rpb_lds[bi]) : -1e30f;
            }
        }
      }
    }
#pragma unroll
    for (int qg = 0; qg < 2; qg++) {
      float ps = 0.f;
#pragma unroll
      for (int kg = 0; kg < 4; kg++)
#pragma unroll
        for (int e = 0; e < 4; e++) {
          float pv = __builtin_amdgcn_exp2f(fmaf(s[kg][qg][e], sc2, -mref2));
          s[kg][qg][e] = pv;
          ps += pv;
        }
      lrun[qg] += ps;
    }
#pragma unroll
    for (int t2 = 0; t2 < 2; t2++) {
      bf16x8 pb[2];
#pragma unroll
      for (int qg = 0; qg < 2; qg++) {
        u32x4 cv;
        cv[0] = pack2(s[2 * t2][qg][0], s[2 * t2][qg][1]);
        cv[1] = pack2(s[2 * t2][qg][2], s[2 * t2][qg][3]);
        cv[2] = pack2(s[2 * t2 + 1][qg][0], s[2 * t2 + 1][qg][1]);
        cv[3] = pack2(s[2 * t2 + 1][qg][2], s[2 * t2 + 1][qg][3]);
        pb[qg] = __builtin_bit_cast(bf16x8, cv);
      }
#pragma unroll
      for (int dg = 0; dg < 4; dg++) {
#pragma unroll
        for (int qg = 0; qg < 2; qg++) o[dg][qg] = __builtin_amdgcn_mfma_f32_16x16x32_bf16(vf[t2][dg], pb[qg], o[dg][qg], 0, 0, 0);
      }
    }
    if (more) {
      u16* K2 = lds + ((it + 1) & 1) * STAGE;
      u16* V2 = K2 + KT;
#pragma unroll
      for (int i = 0; i < NKI; i++) {
        int c = tid + i * 256;
        int row = c / CPR, kc = c % CPR;
        *(u32x4*)(K2 + KOFF(row, kc)) = rk[i];
      }
#pragma unroll
      for (int i = 0; i < 2; i++) {
        int c = tid + i * 256;
        int dv = c >> 3, kc = c & 7;
        *(u32x4*)(V2 + VOFF(dv, kc)) = rv[i];
      }
    }
    __syncthreads();
  }
#pragma unroll
  for (int qg = 0; qg < 2; qg++) {
    float l = lrun[qg];
    l += shfl_xor_f(l, 16);
    l += shfl_xor_f(l, 32);
    const float inv = 1.f / l;
    u16* dst = Op + (size_t)(w * 32 + qg * 16 + l15) * 1024 + quad * 4;
#pragma unroll
    for (int dg = 0; dg < 4; dg++) {
      uint2 v;
      v.x = pack2(o[dg][qg][0] * inv, o[dg][qg][1] * inv);
      v.y = pack2(o[dg][qg][2] * inv, o[dg][qg][3] * inv);
      *(uint2*)(dst + dg * 16) = v;
    }
  }
}
#undef KOFF
#undef VOFF

DEV void conv_tile(const float* __restrict__ src, int K, int N, u16* __restrict__ dst, int kt, int nt, float* lds, const float* __restrict__ kscale) {
  const int tid = opaque_tid();
  __syncthreads();
  {
    float4 v[4];
    const int n4 = (tid & 15) * 4;
    const int gn = nt * 64 + n4;
#pragma unroll
    for (int i = 0; i < 4; i++) {
      const int k = i * 16 + (tid >> 4);
      v[i] = (gn < N) ? *(const float4*)(src + (size_t)(kt * 64 + k) * N + gn) : make_float4(0.f, 0.f, 0.f, 0.f);
      if (kscale) { const float ks = kscale[kt * 64 + k]; v[i].x *= ks; v[i].y *= ks; v[i].z *= ks; v[i].w *= ks; }
    }
#pragma unroll
    for (int i = 0; i < 4; i++) {
      const int k = i * 16 + (tid >> 4);
      float* d = lds + k * 65 + n4;
      d[0] = v[i].x; d[1] = v[i].y; d[2] = v[i].z; d[3] = v[i].w;
    }
  }
  __syncthreads();
#pragma unroll
  for (int i = 0; i < 2; i++) {
    const int c = tid + i * 256;
    const int nn = c >> 3, k8 = (c & 7) * 8;
    float f[8];
#pragma unroll
    for (int e = 0; e < 8; e++) f[e] = lds[(k8 + e) * 65 + nn];
    store8(dst + (size_t)(nt * 64 + nn) * K + kt * 64 + k8, f);
  }
}

constexpr int NCT = 4272;

DEV void phase0(const Params& p, int vb, int G, char* smem) {
  float* ldsf = (float*)smem;
  const int tid = opaque_tid();
  const int total = 2 * NCT + 128 + 192 + 1;
  for (int it0 = vb; it0 < total; it0 += G) {
    const int it = (it0 < 192) ? (2 * NCT + 128 + it0) : ((it0 < 192 + 2 * NCT + 128) ? (it0 - 192) : it0);
    if (it < 2 * NCT) {
      const int l = it / NCT;
      int idx = it - l * NCT;
      u16* W = (u16*)(p.ws + WS_W) + (size_t)l * WL;
      const float* src; u16* dst; int K, N, kt, nt; const float* kscale = nullptr;
      if (idx < 576) { K = 1024; N = 2272; nt = idx >> 4; kt = idx & 15; src = p.in[6] + (size_t)l * 1024 * 2272; dst = W + OW_IN; }
      else if ((idx -= 576) < 1024) { int i = idx >> 8, r = idx & 255; K = 1024; N = 1024; nt = r >> 4; kt = r & 15; src = p.in[22] + (size_t)(l * 4 + i) * 1048576; dst = W + OW_GATE + (size_t)i * 1048576; }
      else if ((idx -= 1024) < 256) { int i = idx >> 6, r = idx & 63; K = 256; N = 1024; nt = r >> 2; kt = r & 3; src = p.in[21] + (size_t)(l * 4 + i) * 262144; dst = W + OW_BRANCH + (size_t)i * 262144; }
      else if ((idx -= 256) < 256) { K = 1024; N = 1024; nt = idx >> 4; kt = idx & 15; src = p.in[24] + (size_t)l * 1048576; dst = W + OW_OUT; }
      else if ((idx -= 256) < 1408) { K = 1024; N = 5632; nt = idx >> 4; kt = idx & 15; src = p.in[25] + (size_t)l * 1024 * 5632; dst = W + OW_UP; }
      else if ((idx -= 1408) < 704) { K = 2816; N = 1024; nt = idx / 44; kt = idx % 44; src = p.in[28] + (size_t)l * 2816 * 1024; dst = W + OW_DOWN; }
      else if ((idx -= 704) < 24) { K = 256; N = 384; nt = idx >> 2; kt = idx & 3; src = p.in[12] + (size_t)l * 256 * 384; dst = W + OW_UQ; kscale = p.in[10] + l * 256; }
      else { idx -= 24; K = 192; N = 512; nt = idx / 3; kt = idx % 3; src = p.in[13] + (size_t)l * 192 * 512; dst = W + OW_UKV; kscale = p.in[11] + l * 192; }
      conv_tile(src, K, N, dst, kt, nt, ldsf, kscale);
    } else if (it < 2 * NCT + 128) {
      const int j = it - 2 * NCT;
      const int l = j >> 6, ch = j & 63;
      const float* src = p.in[17] + (size_t)l * 65536 + ch * 1024;
      u16* dst = (u16*)(p.ws + WS_W) + (size_t)l * WL + OW_SG + ch * 1024;
      float4 v = *(const float4*)(src + tid * 4);
      uint2 o; o.x = pack2(v.x, v.y); o.y = pack2(v.z, v.w);
      *(uint2*)(dst + tid * 4) = o;
    } else if (it < 2 * NCT + 128 + 192) {
      const int j = it - (2 * NCT + 128);
      const int l = j / 96, cb = j % 96;
      __syncthreads();
      float* sc = ldsf;
      float* red = ldsf + 5120;
      for (int i = tid; i < 5120; i += 256) {
        int m = i >> 10, k = i & 1023;
        float c = (m < 4) ? p.in[1][m * 1024 + k] : p.in[3][k];
        sc[i] = silu_f(c);
      }
      __syncthreads();
      const int kg = tid >> 6, n = tid & 63;
      const float* wsrc = p.in[4] + (size_t)l * 1024 * 6144 + cb * 64 + n;
      float a0 = 0, a1 = 0, a2 = 0, a3 = 0, a4 = 0;
#pragma unroll 8
      for (int k = kg * 256; k < kg * 256 + 256; k++) {
        float wv = wsrc[(size_t)k * 6144];
        a0 += sc[k] * wv; a1 += sc[1024 + k] * wv; a2 += sc[2048 + k] * wv; a3 += sc[3072 + k] * wv; a4 += sc[4096 + k] * wv;
      }
      red[(kg * 5 + 0) * 64 + n] = a0; red[(kg * 5 + 1) * 64 + n] = a1; red[(kg * 5 + 2) * 64 + n] = a2;
      red[(kg * 5 + 3) * 64 + n] = a3; red[(kg * 5 + 4) * 64 + n] = a4;
      __syncthreads();
      for (int i = tid; i < 320; i += 256) {
        int m = i >> 6, nn = i & 63;
        float v = red[(0 * 5 + m) * 64 + nn] + red[(1 * 5 + m) * 64 + nn] + red[(2 * 5 + m) * 64 + nn] + red[(3 * 5 + m) * 64 + nn];
        v += p.in[5][(size_t)l * 6144 + cb * 64 + nn];
        ((float*)(p.ws + WS_MOD))[(size_t)(l * 5 + m) * 6144 + cb * 64 + nn] = v;
      }
    } else {
      float2* r16 = (float2*)(p.ws + WS_R16);
      float2* r8 = (float2*)(p.ws + WS_R8);
      for (int i = tid; i < 1024; i += 256) ((unsigned*)(p.ws + WS_ZROW))[i] = 0u;
      for (int i = tid; i < 2048; i += 256) {
        int pos = i >> 4, k = i & 15;
        float inv = powf(10000.f, -(float)k / 16.f);
        float ang = (float)pos * inv;
        r16[i] = make_float2(cosf(ang), sinf(ang));
      }
      for (int i = tid; i < 1024; i += 256) {
        int pos = i >> 3, k = i & 7;
        float inv = powf(10000.f, -(float)k / 8.f);
        float ang = (float)pos * inv;
        r8[i] = make_float2(cosf(ang), sinf(ang));
      }
    }
  }
}

DEV void phase_modulate(const XMap& xin, const float* __restrict__ modl, int shi, int sci, u16* __restrict__ H,
                        bool skip_ctx, int vb, int G) {
  const int tid = opaque_tid(), lane = tid & 63, w = tid >> 6;
  for (int m = vb * 4 + w; m < MM; m += G * 4) {
    const int b = m / SS, s = m - b * SS;
    if (skip_ctx && s < CC) continue;
    const int mrow = (s < CC) ? 4 : b;
    const float* xr = xrow(xin, m);
    float4 v[4];
    float ss = 0.f;
#pragma unroll
    for (int i = 0; i < 4; i++) {
      v[i] = *(const float4*)(xr + i * 256 + lane * 4);
      ss += v[i].x * v[i].x + v[i].y * v[i].y + v[i].z * v[i].z + v[i].w * v[i].w;
    }
#pragma unroll
    for (int o = 32; o >= 1; o >>= 1) ss += shfl_xor_f(ss, o);
    const float rstd = rsqrtf(ss * (1.f / 1024.f) + EPS);
    const float* sh = modl + (size_t)mrow * 6144 + shi * 1024;
    const float* sc = modl + (size_t)mrow * 6144 + sci * 1024;
#pragma unroll
    for (int i = 0; i < 4; i++) {
      const int n = i * 256 + lane * 4;
      float4 a = *(const float4*)(sc + n);
      float4 c = *(const float4*)(sh + n);
      uint2 o;
      o.x = pack2(v[i].x * rstd * (1.f + a.x) + c.x, v[i].y * rstd * (1.f + a.y) + c.y);
      o.y = pack2(v[i].z * rstd * (1.f + a.z) + c.z, v[i].w * rstd * (1.f + a.w) + c.w);
      *(uint2*)(H + (size_t)m * DD + n) = o;
    }
  }
}

DEV void unpack8(const u32x4& v, float (&f)[8]) {
  f[0] = __uint_as_float(v[0] << 16); f[1] = __uint_as_float(v[0] & 0xffff0000u);
  f[2] = __uint_as_float(v[1] << 16); f[3] = __uint_as_float(v[1] & 0xffff0000u);
  f[4] = __uint_as_float(v[2] << 16); f[5] = __uint_as_float(v[2] & 0xffff0000u);
  f[6] = __uint_as_float(v[3] << 16); f[7] = __uint_as_float(v[3] & 0xffff0000u);
}

DEV void head_norm64(float (&v)[8], const float* __restrict__ gain, int c, bool rope, int s, const float2* __restrict__ R16) {
  float ss = 0.f;
#pragma unroll
  for (int e = 0; e < 8; e++) ss += v[e] * v[e];
  ss += shfl_xor_f(ss, 1); ss += shfl_xor_f(ss, 2); ss += shfl_xor_f(ss, 4);
  const float rstd = rsqrtf(ss * (1.f / 64.f) + EPS);
#pragma unroll
  for (int e = 0; e < 8; e++) v[e] *= rstd * gain[c * 8 + e];
  if (rope) {
    const int tl = s - CC;
    const int pos = (c & 4) ? (tl & 63) : (tl >> 6);
#pragma unroll
    for (int e = 0; e < 8; e++) {
      float pr = shfl_xor_f(v[e], 2);
      float2 cs = R16[pos * 16 + (c & 1) * 8 + e];
      v[e] = (c & 2) ? (v[e] * cs.x + pr * cs.y) : (v[e] * cs.x - pr * cs.y);
    }
  }
}

DEV void prep_item(const Params& p, int l, int it, char* smem) {
  u16* Z = (u16*)(p.ws + WS_Z);
  u16* QKV = (u16*)(p.ws + WS_QKV);
  const float2* R16 = (const float2*)(p.ws + WS_R16);
  const float2* R8 = (const float2*)(p.ws + WS_R8);
  float* rstd_l = (float*)smem;
  const float* na_qn = p.in[7] + l * 64;
  const float* na_kn = p.in[8] + l * 64;
  const float* cq_n = p.in[10] + l * 256;
  const float* ckv_n = p.in[11] + l * 192;
  const float* mla_kn = p.in[15] + l * 96;
  const float* sgv_n = p.in[16] + l * 256;
  const float* gq_qn = p.in[19] + l * 64;
  const float* gq_kn = p.in[20] + l * 64;
  {
    const int tid = opaque_tid(), lane = tid & 63, w = tid >> 6;
    const int part = it % 3;
    const int m0 = (it / 3) * 64;
    const int b = m0 / SS, s0 = m0 - b * SS;
    const bool latent = (s0 >= CC);
    if (part == 0) {
      const int c = tid & 7;
#pragma unroll
      for (int g = 0; g < 2; g++) {
        u32x4 raw[4][2];
#pragma unroll
        for (int h = 0; h < 4; h++)
#pragma unroll
          for (int rep = 0; rep < 2; rep++)
            raw[h][rep] = *(const u32x4*)(Z + (size_t)(m0 + rep * 32 + (tid >> 3)) * ZW + g * 256 + h * 64 + c * 8);
        const float* gain = g ? na_kn : na_qn;
#pragma unroll
        for (int h = 0; h < 4; h++)
#pragma unroll
          for (int rep = 0; rep < 2; rep++) {
            const int s = s0 + rep * 32 + (tid >> 3);
            float v[8];
            unpack8(raw[h][rep], v);
            head_norm64(v, gain, c, false, s, R16);
            store8(QKV + (g ? K_NA : Q_NA) + ((size_t)(b * 4 + h) * SS + s) * 64 + c * 8, v);
          }
      }
    } else if (part == 1) {
      const int c = tid & 7;
      {
        u32x4 raw[6][2];
#pragma unroll
        for (int h = 0; h < 6; h++)
#pragma unroll
          for (int rep = 0; rep < 2; rep++)
            raw[h][rep] = *(const u32x4*)(Z + (size_t)(m0 + rep * 32 + (tid >> 3)) * ZW + 1760 + h * 64 + c * 8);
#pragma unroll
        for (int h = 0; h < 6; h++)
#pragma unroll
          for (int rep = 0; rep < 2; rep++) {
            const int s = s0 + rep * 32 + (tid >> 3);
            float v[8];
            unpack8(raw[h][rep], v);
            head_norm64(v, (h < 4) ? gq_qn : gq_kn, c, latent, s, R16);
            u16* dst = (h < 4) ? (QKV + Q_GQA + ((size_t)(b * 4 + h) * SS + s) * 64) : (QKV + K_GQA + ((size_t)(b * 2 + (h - 4)) * SS + s) * 64);
            store8(dst + c * 8, v);
          }
      }
      const int sp = perm32(s0 + lane);
#pragma unroll
      for (int k3 = 0; k3 < 3; k3++) {
        u32x4 raw[4];
#pragma unroll
        for (int q = 0; q < 4; q++) {
          const int ct = w + 4 * (k3 * 4 + q);
          const int srccol = (ct < 32) ? (512 + ct * 8) : (2144 + (ct - 32) * 8);
          raw[q] = *(const u32x4*)(Z + (size_t)(m0 + lane) * ZW + srccol);
        }
#pragma unroll
        for (int q = 0; q < 4; q++) {
          const int ct = w + 4 * (k3 * 4 + q);
          u16* dst;
          if (ct < 32) { int head = ct >> 3, dv0 = (ct & 7) * 8; dst = QKV + V_NA + ((size_t)(b * 4 + head) * 64 + dv0) * SS; }
          else { int cg2 = ct - 32; int head = cg2 >> 3, dv0 = (cg2 & 7) * 8; dst = QKV + V_GQA + ((size_t)(b * 2 + head) * 64 + dv0) * SS; }
          dst += sp;
#pragma unroll
          for (int e = 0; e < 4; e++) {
            dst[(size_t)(2 * e) * SS] = (u16)(raw[q][e] & 0xffff);
            dst[(size_t)(2 * e + 1) * SS] = (u16)(raw[q][e] >> 16);
          }
        }
      }
    } else if (part == 2) {
      __syncthreads();
#pragma unroll
      for (int hb = 0; hb < 2; hb++) {
        u32x4 ru[4], rv2[4];
#pragma unroll
        for (int q = 0; q < 4; q++) {
          const int idx = (hb * 4 + q) * 256 + tid;
          const int t = idx >> 5, c = idx & 31;
          ru[q] = *(const u32x4*)(Z + (size_t)(m0 + t) * ZW + 1248 + c * 8);
          rv2[q] = *(const u32x4*)(Z + (size_t)(m0 + t) * ZW + 1504 + c * 8);
        }
#pragma unroll
        for (int q = 0; q < 4; q++) {
          const int idx = (hb * 4 + q) * 256 + tid;
          const int t = idx >> 5, c = idx & 31;
          float v[8];
          unpack8(ru[q], v);
#pragma unroll
          for (int e = 0; e < 8; e++) v[e] = gelu_f(v[e]);
          store8(QKV + SG_U + (size_t)(m0 + t) * 256 + c * 8, v);
          unpack8(rv2[q], v);
          float ss = 0.f;
#pragma unroll
          for (int e = 0; e < 8; e++) { float g = gelu_f(v[e]); ss += g * g; }
#pragma unroll
          for (int o = 1; o <= 16; o <<= 1) ss += shfl_xor_f(ss, o);
          if (c == 0) rstd_l[t] = rsqrtf(ss * (1.f / 256.f) + EPS);
        }
      }
      __syncthreads();
      {
        u32x4 raw[8];
#pragma unroll
        for (int q = 0; q < 8; q++) raw[q] = *(const u32x4*)(Z + (size_t)(m0 + lane) * ZW + 1504 + (w + 4 * q) * 8);
        const float rs = rstd_l[lane];
        const int mm = m0 + lane;
#pragma unroll
        for (int q = 0; q < 8; q++) {
          const int ct = w + 4 * q;
          float v[8];
          unpack8(raw[q], v);
          u16* dst = QKV + SG_VT + (size_t)(mm >> 7) * 32768 + (size_t)(ct * 8) * 128 + (mm & 127);
#pragma unroll
          for (int e = 0; e < 8; e++) dst[e * 128] = f2bf(gelu_f(v[e]) * rs * sgv_n[ct * 8 + e]);
        }
      }
    }
  }
}

#define XB_TMO      128
#define XB_XCNT(j)  (256  + 64 * (j))
#define XB_XSUB(j)  (1280 + 64 * (j))
#define XB_XGEN(j)  (2304 + 64 * (j))
#define XB_TOP      3328
#define XB_TOPGEN   3392
#define XCD_BAR_WORDS 3456
#define XB_SPIN_CAP (1u << 18)
#define LAS __attribute__((address_space(3)))

__device__ __forceinline__ unsigned xb_ld(unsigned* p)              { return __hip_atomic_load(p, __ATOMIC_RELAXED, __HIP_MEMORY_SCOPE_AGENT); }
__device__ __forceinline__ unsigned xb_add(unsigned* p, unsigned v) { return __hip_atomic_fetch_add(p, v, __ATOMIC_RELAXED, __HIP_MEMORY_SCOPE_AGENT); }
__device__ __forceinline__ unsigned xb_xcc_id() { return (unsigned)__builtin_amdgcn_s_getreg((3 << 11) | 20) & 0xFu; }
#define XB_SPIN(cond, bar) do { unsigned _sp = 0; while (cond) { __builtin_amdgcn_s_sleep(1); \
    if ((++_sp & 255u) == 0u) { if (xb_ld(&(bar)[XB_TMO])) break; if (_sp > XB_SPIN_CAP) { atomicAdd(&(bar)[XB_TMO], 1u); break; } } } } while (0)

struct XcdBarrier {
    unsigned* bar; unsigned x;
    volatile LAS unsigned* st;
};

__device__ __forceinline__ XcdBarrier xcd_barrier_post(unsigned* bar, volatile LAS unsigned* st) {
    XcdBarrier b; b.bar = bar; b.x = (unsigned)__builtin_amdgcn_readfirstlane((int)xb_xcc_id()); b.st = st;
    if (threadIdx.x == 0) (void)xb_add(&bar[XB_XCNT(b.x)], 1u);
    return b;
}
__device__ __forceinline__ void xcd_barrier_complete(unsigned* bar, unsigned x, unsigned& nloc, unsigned& nx) {
    const unsigned G = gridDim.x * gridDim.y * gridDim.z;
    unsigned sum, cnt, mine, sp = 0u;
    for (;;) {
        sum = 0u; cnt = 0u; mine = 0u;
#pragma unroll
        for (unsigned j = 0; j < 16; ++j) { const unsigned c = xb_ld(&bar[XB_XCNT(j)]); sum += c; cnt += (c > 0u) ? 1u : 0u; mine = (j == x) ? c : mine; }
        if (sum == G) break;
        __builtin_amdgcn_s_sleep(1);
        if ((++sp & 255u) == 0u) { if (xb_ld(&bar[XB_TMO])) break; if (sp > XB_SPIN_CAP) { atomicAdd(&bar[XB_TMO], 1u); break; } }
    }
    nloc = mine > 0u ? mine : 1u; nx = cnt > 0u ? cnt : 1u;
}

__device__ __forceinline__ void xcd_barrier(const XcdBarrier& b) {
    asm volatile("s_waitcnt vmcnt(0)" ::: "memory");
    __syncthreads();
    if (threadIdx.x == 0) {
        unsigned* bar = b.bar;
        __builtin_amdgcn_s_waitcnt(0);
        unsigned nloc = b.st[0], nx = b.st[1];
        if (nloc == 0u) { xcd_barrier_complete(bar, b.x, nloc, nx); b.st[0] = nloc; b.st[1] = nx; }
        const unsigned old = xb_add(&bar[XB_XSUB(b.x)], 1u);
        const unsigned gen = old / nloc;
        if (old + 1u == (gen + 1u) * nloc) {
            __builtin_amdgcn_fence(__ATOMIC_RELEASE, "agent");
            asm volatile("s_waitcnt vmcnt(0)" ::: "memory");
            const unsigned og = xb_add(&bar[XB_TOP], 1u);
            const unsigned tg = og / nx;
            if (og + 1u == (tg + 1u) * nx) xb_add(&bar[XB_TOPGEN], 1u);
            else XB_SPIN(xb_ld(&bar[XB_TOPGEN]) == tg, bar);
            __builtin_amdgcn_fence(__ATOMIC_ACQUIRE, "agent");
            xb_add(&bar[XB_XGEN(b.x)], 1u);
            asm volatile("s_waitcnt vmcnt(0)" ::: "memory");
        } else {
            XB_SPIN(xb_ld(&bar[XB_XGEN(b.x)]) == gen, bar);
            __builtin_amdgcn_fence(__ATOMIC_ACQUIRE, "agent");
            asm volatile("s_waitcnt vmcnt(0)" ::: "memory");
        }
    }
    __syncthreads();
}


__global__ void __launch_bounds__(256, 2) fwd_megakernel(Params p) {
  __shared__ __attribute__((aligned(16))) char smem[SMEM_BYTES];
  cg::grid_group grid = cg::this_grid();
  __shared__ __attribute__((aligned(16))) unsigned xb_st[4];
  if (threadIdx.x < 4) xb_st[threadIdx.x] = 0u;
  __syncthreads();
  XcdBarrier xbar = xcd_barrier_post((unsigned*)(p.ws + WS_BAR), (volatile LAS unsigned*)xb_st);
  const int G = gridDim.x;
  const int vb = ((G & 7) == 0) ? ((blockIdx.x & 7) * (G >> 3) + (blockIdx.x >> 3)) : (int)blockIdx.x;
  const int tid = opaque_tid(), lane = tid & 63, w = tid >> 6, l15 = lane & 15, quad = lane >> 4;
  const int wm = w >> 1, wn = w & 1;
  u16* ldsu = (u16*)smem;
  float* ldsf = (float*)smem;

  u16* H = (u16*)(p.ws + WS_H);
  u16* Z = (u16*)(p.ws + WS_Z);
  u16* O = Z;
  u16* Y = Z + (size_t)MM * 1024;
  u16* QKV = (u16*)(p.ws + WS_QKV);
  u16* ACT = QKV;
  const float2* R8 = (const float2*)(p.ws + WS_R8);

  for (int rep_ = 0; rep_ < REP_SYNC; rep_++) grid.sync();
#ifndef SKIP_P0
  for (int rep_ = 0; rep_ < REP_P0; rep_++) phase0(p, vb, G, smem);
#endif
  if (gridDim.y > 1) grid.sync();

  for (int l = 0; l < 2; l++) {
    xcd_barrier(xbar);
    const u16* W = (const u16*)(p.ws + WS_W) + (size_t)l * WL;
    const float* modl = (const float*)(p.ws + WS_MOD) + (size_t)l * 5 * 6144;
    XMap xin, xout;
    if (l == 0) { xin.lat = (float*)p.in[0]; xin.ctx = (float*)p.in[2]; }
    else { xin.lat = p.out; xin.ctx = (float*)(p.ws + WS_CX); }
    xout.lat = p.out; xout.ctx = (float*)(p.ws + WS_CX);
    const bool last = (l == 1);

#ifndef SKIP_P1
    for (int rep_ = 0; rep_ < REP_P1; rep_++) {
    phase_modulate(xin, modl, 0, 1, H, false, vb, G);
    }
#endif
    xcd_barrier(xbar);

#ifndef SKIP_P2
    {
    for (int rep_ = 0; rep_ < REP_P2; rep_++) {
    const int tid = opaque_tid(), lane = tid & 63, w = tid >> 6, l15 = lane & 15, quad = lane >> 4;
    const int wm = w >> 1, wn = w & 1;
    (void)wm; (void)wn; (void)l15; (void)quad;
    for (int it = vb; it < 264 * 9; it += G) {
      const int g8 = it / (8 * 9);
      const int rem = it - g8 * (8 * 9);
      const int nt = rem >> 3;
      const int mt = g8 * 8 + (rem & 7);
      const int m0 = mt * 128, n0 = nt * 256;
      f32x4 acc[4][8];
      gemm_wide([&](int r) { return (const u16*)(H + (size_t)(m0 + r) * DD); },
                [&](int n) { return (const u16*)(W + OW_IN + (size_t)(n0 + n) * 1024); }, 32, acc, ldsu);
      const int tid = opaque_tid(), lane = tid & 63, w = tid >> 6, l15 = lane & 15, quad = lane >> 4, wm = w >> 1, wn = w & 1; (void)lane; (void)wm; (void)wn; (void)l15; (void)quad;
      u16* zb = Z + (size_t)m0 * ZW + n0;
#pragma unroll
      for (int i = 0; i < 4; i++)
#pragma unroll
        for (int j = 0; j < 8; j++)
#pragma unroll
          for (int e = 0; e < 4; e++) zb[ACC_ROW(i, e) * ZW + ACC_COLW(j)] = f2bf(acc[i][j][e]);
    }
    }
    }
#endif
    xcd_barrier(xbar);

#ifndef SKIP_P4
    {
    for (int rep_ = 0; rep_ < REP_P4; rep_++) {
    const int tid = opaque_tid(), lane = tid & 63, w = tid >> 6, l15 = lane & 15, quad = lane >> 4;
    const int wm = w >> 1, wn = w & 1;
    (void)wm; (void)wn; (void)l15; (void)quad;
    {
      const float* mla_qn = p.in[14] + l * 96;
      const float* mla_kn = p.in[15] + l * 96;
      for (int it = vb; it < 264 * 8 + (MM / 64) * 3; it += G) {
        if (it >= 264 * 8) { prep_item(p, l, it - 264 * 8, smem); continue; }
        const int mt = it >> 3, hh = it & 7;
        const int m0 = mt * 128;
        const int b = m0 / SS, s0 = m0 - b * SS;
        if (hh < 4) {
          const int h = hh;
          f32x4 acc[4][3];
          gemm_core<96>([&](int r) { return (const u16*)(Z + (size_t)(m0 + r) * ZW + 768); },
                        [&](int n) { return (const u16*)(W + OW_UQ + (size_t)(h * 96 + n) * 256); }, 4, acc, ldsu);
      const int tid = opaque_tid(), lane = tid & 63, w = tid >> 6, l15 = lane & 15, quad = lane >> 4, wm = w >> 1, wn = w & 1; (void)lane; (void)wm; (void)wn; (void)l15; (void)quad;
          acc_to_lds<96>(acc, ldsf);
          __syncthreads();
          const int t = tid >> 1, hs = tid & 1;
          const int s = s0 + t;
          u16* dst = QKV + Q_MLA + ((size_t)(b * 4 + h) * SS + s) * 96;
          const float* st = ldsf + t * 97;
          float rq;
          {
            const u16* zr = Z + (size_t)(m0 + t) * ZW + 768 + hs * 128;
            u32x4 raw[16];
#pragma unroll
            for (int c = 0; c < 16; c++) raw[c] = *(const u32x4*)(zr + c * 8);
            float sq = 0.f;
#pragma unroll
            for (int c = 0; c < 16; c++) {
              float v[8];
              unpack8(raw[c], v);
#pragma unroll
              for (int e = 0; e < 8; e++) sq += v[e] * v[e];
            }
            sq += shfl_xor_f(sq, 1);
            rq = rsqrtf(sq * (1.f / 256.f) + EPS);
          }
          if (hs == 0) {
            float ss = 0.f;
#pragma unroll
            for (int e = 0; e < 64; e++) ss += st[e] * st[e];
            ss *= rq * rq;
            const float rstd = rq * rsqrtf(ss * (1.f / 64.f) + EPS);
#pragma unroll
            for (int c = 0; c < 8; c++) {
              float v[8];
#pragma unroll
              for (int e = 0; e < 8; e++) v[e] = st[c * 8 + e] * rstd * mla_qn[c * 8 + e];
              store8(dst + c * 8, v);
            }
          } else {
            float ss = 0.f;
#pragma unroll
            for (int e = 0; e < 32; e++) ss += st[64 + e] * st[64 + e];
            ss *= rq * rq;
            const float rstd = rq * rsqrtf(ss * (1.f / 32.f) + EPS);
            float x1[8], x2[8], y1[8], y2[8];
#pragma unroll
            for (int e = 0; e < 8; e++) {
              x1[e] = st[64 + e] * rstd * mla_qn[64 + e];
              x2[e] = st[72 + e] * rstd * mla_qn[72 + e];
              y1[e] = st[80 + e] * rstd * mla_qn[80 + e];
              y2[e] = st[88 + e] * rstd * mla_qn[88 + e];
            }
            if (s >= CC) {
              const int tl = s - CC;
              const int prow = tl >> 6, pcol = tl & 63;
#pragma unroll
              for (int e = 0; e < 8; e++) {
                float2 cr = R8[prow * 8 + e];
                float2 cc = R8[pcol * 8 + e];
                float a1 = x1[e] * cr.x - x2[e] * cr.y;
                float a2 = x2[e] * cr.x + x1[e] * cr.y;
                float b1 = y1[e] * cc.x - y2[e] * cc.y;
                float b2 = y2[e] * cc.x + y1[e] * cc.y;
                x1[e] = a1; x2[e] = a2; y1[e] = b1; y2[e] = b2;
              }
            }
            store8(dst + 64, x1); store8(dst + 72, x2); store8(dst + 80, y1); store8(dst + 88, y2);
          }
        } else {
          const int h = hh - 4;
          f32x4 acc[4][4];
          gemm_core<128>([&](int r) { return (const u16*)(Z + (size_t)(m0 + r) * ZW + 1024); },
                         [&](int n) { return (const u16*)(W + OW_UKV + (size_t)(h * 128 + n) * 192); }, 3, acc, ldsu);
      const int tid = opaque_tid(), lane = tid & 63, w = tid >> 6, l15 = lane & 15, quad = lane >> 4, wm = w >> 1, wn = w & 1; (void)lane; (void)wm; (void)wn; (void)l15; (void)quad;
          acc_to_lds<128>(acc, ldsf);
          __syncthreads();
          float* rs_l = ldsf + 128 * 129;
          {
            const int t = tid >> 1, hs = tid & 1;
            const int s = s0 + t;
            float rkv;
            {
              const u16* zr = Z + (size_t)(m0 + t) * ZW + 1024 + hs * 96;
              u32x4 raw[12];
#pragma unroll
              for (int c = 0; c < 12; c++) raw[c] = *(const u32x4*)(zr + c * 8);
              float sq = 0.f;
#pragma unroll
              for (int c = 0; c < 12; c++) {
                float v[8];
                unpack8(raw[c], v);
#pragma unroll
                for (int e = 0; e < 8; e++) sq += v[e] * v[e];
              }
              sq += shfl_xor_f(sq, 1);
              rkv = rsqrtf(sq * (1.f / 192.f) + EPS);
            }
            if (hs == 1) {
              float x1[8], x2[8], y1[8], y2[8];
              const u16* zk = Z + (size_t)(m0 + t) * ZW + 1216;
              load8(zk, x1); load8(zk + 8, x2); load8(zk + 16, y1); load8(zk + 24, y2);
              float ssr = 0.f;
#pragma unroll
              for (int e = 0; e < 8; e++) ssr += x1[e] * x1[e] + x2[e] * x2[e] + y1[e] * y1[e] + y2[e] * y2[e];
              const float rr = rsqrtf(ssr * (1.f / 32.f) + EPS);
#pragma unroll
              for (int e = 0; e < 8; e++) {
                x1[e] *= rr * mla_kn[64 + e]; x2[e] *= rr * mla_kn[72 + e];
                y1[e] *= rr * mla_kn[80 + e]; y2[e] *= rr * mla_kn[88 + e];
              }
              if (s >= CC) {
                const int tl = s - CC;
                const int prow = tl >> 6, pcol = tl & 63;
#pragma unroll
                for (int e = 0; e < 8; e++) {
                  const float2 cr = R8[prow * 8 + e];
                  const float2 cc2 = R8[pcol * 8 + e];
                  const float a1 = x1[e] * cr.x - x2[e] * cr.y;
                  const float a2 = x2[e] * cr.x + x1[e] * cr.y;
                  const float b1 = y1[e] * cc2.x - y2[e] * cc2.y;
                  const float b2 = y2[e] * cc2.x + y1[e] * cc2.y;
                  x1[e] = a1; x2[e] = a2; y1[e] = b1; y2[e] = b2;
                }
              }
              u16* dstr = QKV + K_MLA + ((size_t)(b * 4 + h) * SS + s) * 96 + 64;
              store8(dstr, x1); store8(dstr + 8, x2); store8(dstr + 16, y1); store8(dstr + 24, y2);
            }
            if (hs == 0) {
              rs_l[t] = rkv;
              const float* st = ldsf + t * 129;
              float ss = 0.f;
#pragma unroll
              for (int e = 0; e < 64; e++) ss += st[e] * st[e];
              ss *= rkv * rkv;
              const float rstd = rkv * rsqrtf(ss * (1.f / 64.f) + EPS);
              u16* dst = QKV + K_MLA + ((size_t)(b * 4 + h) * SS + s) * 96;
#pragma unroll
              for (int c = 0; c < 8; c++) {
                float v[8];
#pragma unroll
                for (int e = 0; e < 8; e++) v[e] = st[c * 8 + e] * rstd * mla_kn[c * 8 + e];
                store8(dst + c * 8, v);
              }
            }
          }
          __syncthreads();
          {
            const int t = tid & 127, half = tid >> 7;
            const int sp = perm32(s0 + t);
            u16* dst = QKV + V_MLA + ((size_t)(b * 4 + h) * 64 + half * 32) * SS + sp;
            const float* st = ldsf + t * 129 + 64 + half * 32;
            const float rkv = rs_l[t];
#pragma unroll 8
            for (int e = 0; e < 32; e++) dst[(size_t)e * SS] = f2bf(st[e] * rkv);
          }
        }
      }
    }
    }
    }
#endif
    xcd_barrier(xbar);

#ifndef SKIP_P6
    {
    for (int rep_ = 0; rep_ < REP_P6; rep_++) {
    const int tid = opaque_tid(), lane = tid & 63, w = tid >> 6, l15 = lane & 15, quad = lane >> 4;
    const int wm = w >> 1, wn = w & 1;
    (void)wm; (void)wn; (void)l15; (void)quad;
    {
      const float sc_mla = 0.10206207261596575f * LOG2E;
      const float sc_64 = 0.125f * LOG2E;
      float* rpb_lds = (float*)(smem + 49152);
      const float* rpb = p.in[9] + (size_t)l * 4 * 465;
      const float* sgb = p.in[18] + (size_t)l * 512;
      const int nctx = last ? 0 : 96;
      float mref_mla, mref_gqa, mref_na;
      {
        float* red = (float*)(smem + 60000);
        __syncthreads();
        if (w == 0) {
          auto amax = [&](const float* v, int lo, int hi) {
            float m = 0.f;
            for (int i = lo + lane; i < hi; i += 64) m = fmaxf(m, fabsf(v[i]));
#pragma unroll
            for (int o = 32; o >= 1; o >>= 1) m = fmaxf(m, shfl_xor_f(m, o));
            return m;
          };
          const float naq = amax(p.in[7] + l * 64, 0, 64), nak = amax(p.in[8] + l * 64, 0, 64);
          const float gqq = amax(p.in[19] + l * 64, 0, 64), gqk = amax(p.in[20] + l * 64, 0, 64);
          const float mq1 = amax(p.in[14] + l * 96, 0, 64), mq2 = amax(p.in[14] + l * 96, 64, 96);
          const float mk1 = amax(p.in[15] + l * 96, 0, 64), mk2 = amax(p.in[15] + l * 96, 64, 96);
          const float rb = amax(rpb, 0, 4 * 465);
          if (lane == 0) {
            red[0] = sqrtf(64.f * mq1 * mq1 + 32.f * mq2 * mq2) * sqrtf(64.f * mk1 * mk1 + 32.f * mk2 * mk2) * 0.10206207261596575f * LOG2E;
            red[1] = 8.f * gqq * 8.f * gqk * 0.125f * LOG2E;
            red[2] = (8.f * naq * 8.f * nak * 0.125f + rb) * LOG2E;
          }
        }
        __syncthreads();
        mref_mla = red[0]; mref_gqa = red[1]; mref_na = red[2];
      }
      const int total = 1024 + 1024 + 1024 + 1056 + nctx;
      for (int it = vb; it < total; it += G) {
        int kind;
        const u16* Qp = nullptr; const u16* Kp = nullptr; const u16* Vp = nullptr; u16* Op = nullptr;
        int q0 = 0, t0 = 0, n0 = 0, t1 = 0, n1 = 0, r0 = 0, hsel = 0;
        int sg_ec = 0, sg_g = 0;
        float mref1 = mref_gqa;
        if (it < 3072) {
          const int typ = it >> 10;
          const int j = it & 1023;
          const int qt = j & 63, h = (j >> 6) & 3, b = j >> 8;
          q0 = CC + qt * 128;
          hsel = h;
          if (typ == 0) {
            kind = 0;
            Qp = QKV + Q_MLA + (size_t)(b * 4 + h) * SS * 96; Kp = QKV + K_MLA + (size_t)(b * 4 + h) * SS * 96;
            Vp = QKV + V_MLA + (size_t)(b * 4 + h) * 64 * SS; Op = O + (size_t)(b * SS + q0) * 1024 + 256 + h * 64;
            t0 = 0; n0 = 132;
          } else if (typ == 1) {
            kind = 1;
            const int g = h >> 1;
            Qp = QKV + Q_GQA + (size_t)(b * 4 + h) * SS * 64; Kp = QKV + K_GQA + (size_t)(b * 2 + g) * SS * 64;
            Vp = QKV + V_GQA + (size_t)(b * 2 + g) * 64 * SS; Op = O + (size_t)(b * SS + q0) * 1024 + 768 + h * 64;
            t0 = 0; n0 = 132;
          } else {
            kind = 2;
            r0 = qt * 2;
            const int bs = clampi(r0 - 4, 0, 120);
            const int be = clampi(r0 + 1 - 4, 0, 120) + 8;
            Qp = QKV + Q_NA + (size_t)(b * 4 + h) * SS * 64; Kp = QKV + K_NA + (size_t)(b * 4 + h) * SS * 64;
            Vp = QKV + V_NA + (size_t)(b * 4 + h) * 64 * SS; Op = O + (size_t)(b * SS + q0) * 1024 + 0 + h * 64;
            t0 = 0; n0 = 4; t1 = 4 + bs; n1 = be - bs;
          }
        } else if (it < 3072 + 1056) {
          kind = 3;
          const int j = it - 3072;
          sg_ec = j >> 2; sg_g = j & 3;
        } else {
          const int j = it - (3072 + 1056);
          const int typ = j >> 5, rem = j & 31;
          const int qt = rem & 1, h = (rem >> 1) & 3, b = rem >> 3;
          q0 = qt * 128;
          t0 = 0; n0 = 4;
          if (typ == 1) {
            kind = 0;
            Qp = QKV + Q_MLA + (size_t)(b * 4 + h) * SS * 96; Kp = QKV + K_MLA + (size_t)(b * 4 + h) * SS * 96;
            Vp = QKV + V_MLA + (size_t)(b * 4 + h) * 64 * SS; Op = O + (size_t)(b * SS + q0) * 1024 + 256 + h * 64;
          } else if (typ == 0) {
            kind = 1;
            mref1 = mref_na;
            Qp = QKV + Q_NA + (size_t)(b * 4 + h) * SS * 64; Kp = QKV + K_NA + (size_t)(b * 4 + h) * SS * 64;
            Vp = QKV + V_NA + (size_t)(b * 4 + h) * 64 * SS; Op = O + (size_t)(b * SS + q0) * 1024 + 0 + h * 64;
          } else {
            kind = 1;
            const int g = h >> 1;
            Qp = QKV + Q_GQA + (size_t)(b * 4 + h) * SS * 64; Kp = QKV + K_GQA + (size_t)(b * 2 + g) * SS * 64;
            Vp = QKV + V_GQA + (size_t)(b * 2 + g) * 64 * SS; Op = O + (size_t)(b * SS + q0) * 1024 + 768 + h * 64;
          }
        }
        if (kind == 0) {
#ifndef NO_A96
          attn_item<96, false>(Qp, Kp, Vp, q0, t0, n0, t1, n1, sc_mla, mref_mla, Op, 0, nullptr, ldsu, rpb_lds);
#endif
        } else if (kind == 1) {
#ifndef NO_A64
          attn_item<64, false>(Qp, Kp, Vp, q0, t0, n0, t1, n1, sc_64, mref1, Op, 0, nullptr, ldsu, rpb_lds);
#endif
        } else if (kind == 2) {
#ifndef NO_NA
          attn_item<64, true>(Qp, Kp, Vp, q0, t0, n0, t1, n1, sc_64, mref_na, Op, r0, rpb + hsel * 465, ldsu, rpb_lds);
#endif
        } else {
          const int ec = sg_ec, g = sg_g;
          f32x4 acc[4][2];
          gemm_core<64>([&](int r) { return (const u16*)(W + OW_SG + (size_t)(g * 128 + r) * 128); },
                        [&](int n) { return (const u16*)(QKV + SG_VT + (size_t)ec * 32768 + (size_t)(g * 64 + n) * 128); }, 2, acc, ldsu);
      const int tid = opaque_tid(), lane = tid & 63, w = tid >> 6, l15 = lane & 15, quad = lane >> 4, wm = w >> 1, wn = w & 1; (void)lane; (void)wm; (void)wn; (void)l15; (void)quad;
          asm volatile("" ::: "memory");
          const u16* ub = QKV + SG_U + (size_t)ec * 128 * 256 + g * 64;
          u16* ob = O + (size_t)ec * 128 * 1024 + 512 + g * 64;
          const float* sb = sgb + g * 128;
          float uu[4][2][4];
#pragma unroll
          for (int i = 0; i < 4; i++)
#pragma unroll
            for (int jj = 0; jj < 2; jj++)
#pragma unroll
              for (int e = 0; e < 4; e++) uu[i][jj][e] = bf2f(ub[ACC_ROW(i, e) * 256 + ACC_COL(64, jj)]);
#pragma unroll
          for (int i = 0; i < 4; i++)
#pragma unroll
            for (int e = 0; e < 4; e++) {
              const int pr = ACC_ROW(i, e);
              const float bb = sb[pr];
#pragma unroll
              for (int jj = 0; jj < 2; jj++) ob[pr * 1024 + ACC_COL(64, jj)] = f2bf(uu[i][jj][e] * (acc[i][jj][e] + bb));
            }
        }
      }
    }

    }
    }
#endif
    xcd_barrier(xbar);

#ifndef SKIP_P7
    {
    for (int rep_ = 0; rep_ < REP_P7; rep_++) {
    const int tid = opaque_tid(), lane = tid & 63, w = tid >> 6, l15 = lane & 15, quad = lane >> 4;
    const int wm = w >> 1, wn = w & 1;
    (void)wm; (void)wn; (void)l15; (void)quad;
    {
      const float* bg = p.in[23] + (size_t)l * 4096;
      for (int it = vb; it < (last ? 256 : 264) * 16; it += G) {
        const int mi = it >> 4, nt = it & 15;
        const int mt = last ? ((mi >> 6) * 66 + 2 + (mi & 63)) : mi;
        const int m0 = mt * 128, n0 = nt * 64;
        f32x4 y[4][2];
#pragma unroll
        for (int i = 0; i < 4; i++)
#pragma unroll
          for (int j = 0; j < 2; j++) y[i][j] = f32x4{0.f, 0.f, 0.f, 0.f};
        for (int br = 0; br < 4; br++) {
          f32x4 ag[4][2], ap2[4][2];
          gemm_dual<64>([&](int r) { return (const u16*)(H + (size_t)(m0 + r) * DD); },
                        [&](int n) { return (const u16*)(W + OW_GATE + (size_t)br * 1048576 + (size_t)(n0 + n) * 1024); }, 16, ag,
                        [&](int r) { return (const u16*)(O + (size_t)(m0 + r) * 1024 + br * 256); },
                        [&](int n) { return (const u16*)(W + OW_BRANCH + (size_t)br * 262144 + (size_t)(n0 + n) * 256); }, 4, ap2, ldsu);
      const int tid = opaque_tid(), lane = tid & 63, w = tid >> 6, l15 = lane & 15, quad = lane >> 4, wm = w >> 1, wn = w & 1; (void)lane; (void)wm; (void)wn; (void)l15; (void)quad;
#pragma unroll
          for (int j = 0; j < 2; j++) {
            const float bv = bg[br * 1024 + n0 + ACC_COL(64, j)];
#pragma unroll
            for (int i = 0; i < 4; i++)
#pragma unroll
              for (int e = 0; e < 4; e++) y[i][j][e] += sigmoid_f(ag[i][j][e] + bv) * ap2[i][j][e];
          }
        }
#pragma unroll
        for (int i = 0; i < 4; i++)
#pragma unroll
          for (int j = 0; j < 2; j++)
#pragma unroll
            for (int e = 0; e < 4; e++) Y[(size_t)(m0 + ACC_ROW(i, e)) * 1024 + n0 + ACC_COL(64, j)] = f2bf(y[i][j][e]);
      }
    }
    }
    }
#endif
    xcd_barrier(xbar);

#ifndef SKIP_P8
    {
    {
    const int tid = opaque_tid(), lane = tid & 63, w = tid >> 6, l15 = lane & 15, quad = lane >> 4;
    const int wm = w >> 1, wn = w & 1;
    (void)wm; (void)wn; (void)l15; (void)quad;
    {
    const int nwide = 256 * 4;
    const int total_items = nwide + (last ? 0 : 64);
    for (int it = vb; it < total_items; it += G) {
      if (it < nwide) {
        const int mi = it >> 2, nt = it & 3;
        const int mt = (mi >> 6) * 66 + 2 + (mi & 63);
        const int m0 = mt * 128, n0 = nt * 256;
        const int b = m0 / SS;
        f32x4 acc[4][8];
        gemm_wide([&](int r) { return (const u16*)(Y + (size_t)(m0 + r) * 1024); },
                  [&](int n) { return (const u16*)(W + OW_OUT + (size_t)(n0 + n) * 1024); }, 32, acc, ldsu);
        const int tid = opaque_tid(), lane = tid & 63, w = tid >> 6, l15 = lane & 15, quad = lane >> 4, wm = w >> 1, wn = w & 1; (void)lane; (void)wm; (void)wn; (void)l15; (void)quad;
        const float* g1 = modl + (size_t)b * 6144 + 2 * 1024;
        const float* xi = xrow(xin, m0) + n0;
        float* xo = xrow(xout, m0) + n0;
        asm volatile("" ::: "memory");
#pragma unroll
        for (int jh = 0; jh < 4; jh++) {
          float xv[2][4][4];
#pragma unroll
          for (int j = 0; j < 2; j++)
#pragma unroll
            for (int i = 0; i < 4; i++)
#pragma unroll
              for (int e = 0; e < 4; e++) xv[j][i][e] = xi[ACC_ROW(i, e) * 1024 + ACC_COLW(jh * 2 + j)];
#pragma unroll
          for (int j = 0; j < 2; j++) {
            const float gv = g1[n0 + ACC_COLW(jh * 2 + j)];
#pragma unroll
            for (int i = 0; i < 4; i++)
#pragma unroll
              for (int e = 0; e < 4; e++) xo[ACC_ROW(i, e) * 1024 + ACC_COLW(jh * 2 + j)] = xv[j][i][e] + gv * acc[i][jh * 2 + j][e];
          }
        }
        continue;
      }
      const int jc = it - nwide;
      const int mc = jc >> 3, nt = jc & 7;
      const int mt = (mc >> 1) * 66 + (mc & 1);
      const int m0 = mt * 128, n0 = nt * 128;
      const int b = m0 / SS, s0 = m0 - b * SS;
      const int mrow = (s0 < CC) ? 4 : b;
      f32x4 acc[4][4];
      gemm_core<128>([&](int r) { return (const u16*)(Y + (size_t)(m0 + r) * 1024); },
                     [&](int n) { return (const u16*)(W + OW_OUT + (size_t)(n0 + n) * 1024); }, 16, acc, ldsu);
      const int tid = opaque_tid(), lane = tid & 63, w = tid >> 6, l15 = lane & 15, quad = lane >> 4, wm = w >> 1, wn = w & 1; (void)lane; (void)wm; (void)wn; (void)l15; (void)quad;
      const float* g1 = modl + (size_t)mrow * 6144 + 2 * 1024;
      const float* xi = xrow(xin, m0) + n0;
      float* xo = xrow(xout, m0) + n0;
      asm volatile("" ::: "memory");
#pragma unroll
      for (int jh = 0; jh < 2; jh++) {
        float xv[2][4][4];
#pragma unroll
        for (int j = 0; j < 2; j++)
#pragma unroll
          for (int i = 0; i < 4; i++)
#pragma unroll
            for (int e = 0; e < 4; e++) xv[j][i][e] = xi[ACC_ROW(i, e) * 1024 + ACC_COL(128, jh * 2 + j)];
#pragma unroll
        for (int j = 0; j < 2; j++) {
          const float gv = g1[n0 + ACC_COL(128, jh * 2 + j)];
#pragma unroll
          for (int i = 0; i < 4; i++)
#pragma unroll
            for (int e = 0; e < 4; e++) xo[ACC_ROW(i, e) * 1024 + ACC_COL(128, jh * 2 + j)] = xv[j][i][e] + gv * acc[i][jh * 2 + j][e];
        }
      }
    }
    }
    }
    }
#endif
    xcd_barrier(xbar);

#ifndef SKIP_P9
    for (int rep_ = 0; rep_ < REP_P9; rep_++) {
    phase_modulate(xout, modl, 3, 4, H, last, vb, G);
    }
#endif
    xcd_barrier(xbar);

#ifndef SKIP_P10
    {
    for (int rep_ = 0; rep_ < REP_P10; rep_++) {
    const int tid = opaque_tid(), lane = tid & 63, w = tid >> 6, l15 = lane & 15, quad = lane >> 4;
    const int wm = w >> 1, wn = w & 1;
    (void)wm; (void)wn; (void)l15; (void)quad;
    {
      const float* cw = p.in[26] + (size_t)l * 3 * 5632;
      const float* cb = p.in[27] + (size_t)l * 5632;
      const int tpb = last ? 66 : 69;
      const int total = NB * tpb * 22;
      for (int it = vb; it < total; it += G) {
        const int MT = NB * tpb;
        const int g8 = it / (8 * 22);
        const int rem = it - g8 * (8 * 22);
        const int gsz = (MT - g8 * 8) < 8 ? (MT - g8 * 8) : 8;
        const int nt = rem / gsz;
        const int mt = g8 * 8 + (rem - nt * gsz);
        const int b = mt / tpb;
        int ti = mt - b * tpb;
        int seg_lo, seg_hi;
        if (last) { seg_lo = CC; seg_hi = SS; }
        else if (ti < 3) { seg_lo = 0; seg_hi = CC; }
        else { ti -= 3; seg_lo = CC; seg_hi = SS; }
        const int sfirst = seg_lo + 126 * ti - 1;
        const int c0 = nt * 128;
        f32x4 acc[4][8];
        gemm_wide([&](int r) { int s = sfirst + r; return (s >= seg_lo && s < seg_hi) ? (const u16*)(H + (size_t)(b * SS + s) * DD) : (const u16*)(p.ws + WS_ZROW); },
                  [&](int n) { int ch = ((n >> 7) ? FF : 0) + c0 + (n & 127); return (const u16*)(W + OW_UP + (size_t)ch * 1024); }, 32, acc, ldsu);
      const int tid = opaque_tid(), lane = tid & 63, w = tid >> 6, l15 = lane & 15, quad = lane >> 4, wm = w >> 1, wn = w & 1; (void)lane; (void)wm; (void)wn; (void)l15; (void)quad;
#pragma unroll
        for (int pss = 0; pss < 2; pss++) {
        if (pss) __syncthreads();
#pragma unroll
        for (int i = 0; i < 4; i++)
#pragma unroll
          for (int j = 0; j < 4; j++)
            *(f32x4*)(ldsf + ACC_COL(128, j) * 132 + wm * 64 + i * 16 + quad * 4) = acc[i][pss * 4 + j];
        __syncthreads();
        const int cc = tid & 63, rg = tid >> 6;
        const int ch = c0 + pss * 64 + cc;
        const float wa0 = cw[ch], wa1 = cw[5632 + ch], wa2 = cw[2 * 5632 + ch], ba = cb[ch];
        const float wg0 = cw[FF + ch], wg1 = cw[5632 + FF + ch], wg2 = cw[2 * 5632 + FF + ch], bgv = cb[FF + ch];
        u16* actb = ACT + (size_t)(b * SS) * FF + ch;
        const float* sa = ldsf + cc * 132;
        const float* sg = ldsf + (64 + cc) * 132;
#pragma unroll 4
        for (int i = 0; i < 8; i++) {
          const int r0 = (rg + 4 * i) * 4;
          const f32x4 a4 = *(const f32x4*)(sa + r0);
          const f32x4 g4 = *(const f32x4*)(sg + r0);
          const float am = (r0 > 0) ? sa[r0 - 1] : 0.f, ap = sa[r0 + 4];
          const float gm = (r0 > 0) ? sg[r0 - 1] : 0.f, gp = sg[r0 + 4];
          float av[4], gv[4];
          av[0] = wa0 * am + wa1 * a4[0] + wa2 * a4[1] + ba;
          av[1] = wa0 * a4[0] + wa1 * a4[1] + wa2 * a4[2] + ba;
          av[2] = wa0 * a4[1] + wa1 * a4[2] + wa2 * a4[3] + ba;
          av[3] = wa0 * a4[2] + wa1 * a4[3] + wa2 * ap + ba;
          gv[0] = wg0 * gm + wg1 * g4[0] + wg2 * g4[1] + bgv;
          gv[1] = wg0 * g4[0] + wg1 * g4[1] + wg2 * g4[2] + bgv;
          gv[2] = wg0 * g4[1] + wg1 * g4[2] + wg2 * g4[3] + bgv;
          gv[3] = wg0 * g4[2] + wg1 * g4[3] + wg2 * gp + bgv;
#pragma unroll
          for (int e = 0; e < 4; e++) {
            const int r = r0 + e;
            const int s = sfirst + r;
            if (r >= 1 && r <= 126 && s >= seg_lo && s < seg_hi) actb[(size_t)s * FF] = f2bf(silu_f(gv[e]) * av[e]);
          }
        }
        }
      }
    }
    }
    }
#endif
    xcd_barrier(xbar);

#ifndef SKIP_P11
    {
    {
    const int tid = opaque_tid(), lane = tid & 63, w = tid >> 6, l15 = lane & 15, quad = lane >> 4;
    const int wm = w >> 1, wn = w & 1;
    (void)wm; (void)wn; (void)l15; (void)quad;
    {
    const int nwide = 256 * 4;
    const int total_items = nwide + (last ? 0 : 64);
    for (int it = vb; it < total_items; it += G) {
      if (it < nwide) {
        const int mi = it >> 2, nt = it & 3;
        const int mt = (mi >> 6) * 66 + 2 + (mi & 63);
        const int m0 = mt * 128, n0 = nt * 256;
        const int b = m0 / SS;
        f32x4 acc[4][8];
        gemm_wide([&](int r) { return (const u16*)(ACT + (size_t)(m0 + r) * FF); },
                  [&](int n) { return (const u16*)(W + OW_DOWN + (size_t)(n0 + n) * FF); }, 88, acc, ldsu);
        const int tid = opaque_tid(), lane = tid & 63, w = tid >> 6, l15 = lane & 15, quad = lane >> 4, wm = w >> 1, wn = w & 1; (void)lane; (void)wm; (void)wn; (void)l15; (void)quad;
        const float* g2 = modl + (size_t)b * 6144 + 5 * 1024;

        float* xo = xrow(xout, m0) + n0;
        asm volatile("" ::: "memory");
#pragma unroll
        for (int jh = 0; jh < 4; jh++) {
          float xv[2][4][4];
#pragma unroll
          for (int j = 0; j < 2; j++)
#pragma unroll
            for (int i = 0; i < 4; i++)
#pragma unroll
              for (int e = 0; e < 4; e++) xv[j][i][e] = xo[ACC_ROW(i, e) * 1024 + ACC_COLW(jh * 2 + j)];
#pragma unroll
          for (int j = 0; j < 2; j++) {
            const float gv = g2[n0 + ACC_COLW(jh * 2 + j)];
#pragma unroll
            for (int i = 0; i < 4; i++)
#pragma unroll
              for (int e = 0; e < 4; e++) xo[ACC_ROW(i, e) * 1024 + ACC_COLW(jh * 2 + j)] = xv[j][i][e] + gv * acc[i][jh * 2 + j][e];
          }
        }
        continue;
      }
      const int jc = it - nwide;
      const int mc = jc >> 3, nt = jc & 7;
      const int mt = (mc >> 1) * 66 + (mc & 1);
      const int m0 = mt * 128, n0 = nt * 128;
      const int b = m0 / SS, s0 = m0 - b * SS;
      const int mrow = (s0 < CC) ? 4 : b;
      f32x4 acc[4][4];
      gemm_core<128>([&](int r) { return (const u16*)(ACT + (size_t)(m0 + r) * FF); },
                     [&](int n) { return (const u16*)(W + OW_DOWN + (size_t)(n0 + n) * FF); }, 44, acc, ldsu);
      const int tid = opaque_tid(), lane = tid & 63, w = tid >> 6, l15 = lane & 15, quad = lane >> 4, wm = w >> 1, wn = w & 1; (void)lane; (void)wm; (void)wn; (void)l15; (void)quad;
      const float* g2 = modl + (size_t)mrow * 6144 + 5 * 1024;
      float* xo = xrow(xout, m0) + n0;
      asm volatile("" ::: "memory");
#pragma unroll
      for (int jh = 0; jh < 2; jh++) {
        float xv[2][4][4];
#pragma unroll
        for (int j = 0; j < 2; j++)
#pragma unroll
          for (int i = 0; i < 4; i++)
#pragma unroll
            for (int e = 0; e < 4; e++) xv[j][i][e] = xo[ACC_ROW(i, e) * 1024 + ACC_COL(128, jh * 2 + j)];
#pragma unroll
        for (int j = 0; j < 2; j++) {
          const float gv = g2[n0 + ACC_COL(128, jh * 2 + j)];
#pragma unroll
          for (int i = 0; i < 4; i++)
#pragma unroll
            for (int e = 0; e < 4; e++) xo[ACC_ROW(i, e) * 1024 + ACC_COL(128, jh * 2 + j)] = xv[j][i][e] + gv * acc[i][jh * 2 + j][e];
        }
      }
    }
    }
    }
    }
#endif
  }
}

extern "C" void kernel_launch(void* const* d_in, const int* in_sizes, int n_in, void* d_out, int out_size,
                              void* d_ws, size_t ws_size, hipStream_t stream) {
  static int grid_blocks = 0;
  if (!grid_blocks) {
    int dev = 0, cus = 0, per_cu = 0;
    (void)hipGetDevice(&dev);
    (void)hipDeviceGetAttribute(&cus, hipDeviceAttributeMultiprocessorCount, dev);
    (void)hipOccupancyMaxActiveBlocksPerMultiprocessor(&per_cu, fwd_megakernel, 256, 0);
    if (per_cu > 2) per_cu = 2;
    if (per_cu < 1) per_cu = 1;
    grid_blocks = cus * per_cu;
    if (ws_size < WS_END) fprintf(stderr, "workspace too small: %zu < %zu\n", ws_size, (size_t)WS_END);
  }
  Params p{};
  for (int i = 0; i < 29; i++) p.in[i] = (const float*)d_in[i];
  p.out = (float*)d_out;
  p.ws = (char*)d_ws;
  p.pad = 0;
  (void)hipMemsetAsync((char*)d_ws + WS_BAR, 0, 3456 * 4, stream);
  void* args[] = {&p};
  hipError_t e = hipLaunchCooperativeKernel((void*)fwd_megakernel, dim3(grid_blocks), dim3(256), args, 0, stream);
  if (e != hipSuccess) fprintf(stderr, "cooperative launch failed: %s (grid %d)\n", hipGetErrorString(e), grid_blocks);
}
```

```cpp
#include <hip/hip_runtime.h>
#include <hip/hip_bf16.h>
#include <hip/hip_cooperative_groups.h>
#include <cstdio>
#include <cstdint>
namespace cg = cooperative_groups;

typedef unsigned short u16;
using bf16x8 = __attribute__((ext_vector_type(8))) short;
using f32x4 = __attribute__((ext_vector_type(4))) float;
using u32x4 = __attribute__((ext_vector_type(4))) unsigned;

#define DEV __device__ __forceinline__
#ifndef REP_P0
#define REP_P0 1
#endif
#ifndef REP_SYNC
#define REP_SYNC 0
#endif
#ifndef REP_P3
#define REP_P3 1
#endif
#ifndef REP_P8
#define REP_P8 1
#endif
#ifndef REP_P11
#define REP_P11 1
#endif
#ifndef REP_P1
#define REP_P1 1
#endif
#ifndef REP_P2
#define REP_P2 1
#endif
#ifndef REP_P4
#define REP_P4 1
#endif
#ifndef REP_P6
#define REP_P6 1
#endif
#ifndef REP_P7
#define REP_P7 1
#endif
#ifndef REP_P9
#define REP_P9 1
#endif
#ifndef REP_P10
#define REP_P10 1
#endif

constexpr int NB = 4, TT = 8192, CC = 256, SS = 8448, MM = NB * SS, DD = 1024;
constexpr int ZW = 2304, FF = 2816;
constexpr float EPS = 1e-6f;
constexpr float LOG2E = 1.4426950408889634f;

constexpr size_t OW_IN = 0;
constexpr size_t OW_GATE = OW_IN + (size_t)2304 * 1024;
constexpr size_t OW_BRANCH = OW_GATE + (size_t)4 * 1024 * 1024;
constexpr size_t OW_OUT = OW_BRANCH + (size_t)4 * 1024 * 256;
constexpr size_t OW_UP = OW_OUT + (size_t)1024 * 1024;
constexpr size_t OW_DOWN = OW_UP + (size_t)5632 * 1024;
constexpr size_t OW_UQ = OW_DOWN + (size_t)1024 * 2816;
constexpr size_t OW_UKV = OW_UQ + (size_t)384 * 256;
constexpr size_t OW_SG = OW_UKV + (size_t)512 * 192;
constexpr size_t WL = OW_SG + (size_t)4 * 128 * 128;

constexpr size_t WS_W = 0;
constexpr size_t WS_MOD = WS_W + 2 * WL * 2;
constexpr size_t WS_R16 = WS_MOD + (size_t)2 * 5 * 6144 * 4;
constexpr size_t WS_R8 = WS_R16 + (size_t)128 * 16 * 8;
constexpr size_t WS_CX = WS_R8 + (size_t)128 * 8 * 8;
constexpr size_t WS_H = WS_CX + (size_t)NB * CC * DD * 4;
constexpr size_t WS_Z = WS_H + (size_t)MM * DD * 2;
constexpr size_t WS_QKV = WS_Z + (size_t)MM * ZW * 2;
constexpr size_t WS_ZROW = WS_QKV + (size_t)MM * FF * 2;
constexpr size_t WS_BAR = WS_ZROW + 4096;
constexpr size_t WS_END = WS_BAR + 3456 * 4;

constexpr size_t Q_NA = 0;
constexpr size_t K_NA = (size_t)MM * 256;
constexpr size_t V_NA = (size_t)MM * 512;
constexpr size_t Q_MLA = (size_t)MM * 768;
constexpr size_t K_MLA = (size_t)MM * 1152;
constexpr size_t V_MLA = (size_t)MM * 1536;
constexpr size_t Q_GQA = (size_t)MM * 1792;
constexpr size_t K_GQA = (size_t)MM * 2048;
constexpr size_t V_GQA = (size_t)MM * 2176;
constexpr size_t SG_U = (size_t)MM * 2304;
constexpr size_t SG_VT = (size_t)MM * 2560;

constexpr int SMEM_BYTES = 67584;

struct Params {
  const float* in[29];
  float* out;
  char* ws;
  long pad;
};

DEV float bf2f(u16 h) { return __uint_as_float(((unsigned)h) << 16); }
DEV u16 f2bf(float f) {
  __bf16 r = (__bf16)f;
  return __builtin_bit_cast(u16, r);
}
typedef __bf16 bf16x2_t __attribute__((ext_vector_type(2)));
typedef float f32x2_t __attribute__((ext_vector_type(2)));
DEV unsigned pack2(float a, float b) {
  f32x2_t v = {a, b};
  bf16x2_t r = __builtin_convertvector(v, bf16x2_t);
  return __builtin_bit_cast(unsigned, r);
}
DEV void load8(const u16* p, float (&f)[8]) {
  uint4 v = *(const uint4*)p;
  f[0] = __uint_as_float(v.x << 16); f[1] = __uint_as_float(v.x & 0xffff0000u);
  f[2] = __uint_as_float(v.y << 16); f[3] = __uint_as_float(v.y & 0xffff0000u);
  f[4] = __uint_as_float(v.z << 16); f[5] = __uint_as_float(v.z & 0xffff0000u);
  f[6] = __uint_as_float(v.w << 16); f[7] = __uint_as_float(v.w & 0xffff0000u);
}
DEV void store8(u16* p, const float (&f)[8]) {
  uint4 v;
  v.x = pack2(f[0], f[1]); v.y = pack2(f[2], f[3]); v.z = pack2(f[4], f[5]); v.w = pack2(f[6], f[7]);
  *(uint4*)p = v;
}
DEV float silu_f(float x) { return x * __builtin_amdgcn_rcpf(1.f + __expf(-x)); }
DEV float sigmoid_f(float x) { return __builtin_amdgcn_rcpf(1.f + __expf(-x)); }
DEV float gelu_f(float x) {
  float y = 0.7978845608028654f * (x + 0.044715f * x * x * x);
  float t = 1.f - 2.f * __builtin_amdgcn_rcpf(__expf(2.f * y) + 1.f);
  return 0.5f * x * (1.f + t);
}
DEV int perm32(int s) {
  int k = s & 31;
  int pos = ((k >> 2) & 3) * 8 + (k >> 4) * 4 + (k & 3);
  return (s & ~31) | pos;
}
DEV int opaque_tid() { int t = threadIdx.x; asm volatile("" : "+v"(t)); return t; }
DEV float shfl_xor_f(float v, int mask) {
  int ln = __builtin_amdgcn_mbcnt_hi(~0u, __builtin_amdgcn_mbcnt_lo(~0u, 0u));
  asm volatile("" : "+v"(ln));
  return __int_as_float(__builtin_amdgcn_ds_bpermute((ln ^ mask) << 2, __float_as_int(v)));
}
DEV int clampi(int v, int lo, int hi) { return v < lo ? lo : (v > hi ? hi : v); }

struct XMap { float* lat; float* ctx; };
DEV float* xrow(const XMap& xm, int m) {
  int b = m / SS;
  int s = m - b * SS;
  return s < CC ? xm.ctx + ((size_t)(b * CC + s)) * DD : xm.lat + ((size_t)(b * TT + s - CC)) * DD;
}

template <int BN, class AF, class BF>
DEV void gemm_core(AF arow, BF brow, int nk, f32x4 (&acc)[4][BN / 32], u16* lds) {
  constexpr int NF = BN / 32;
  constexpr int STAGE = (128 + BN) * 64;
  constexpr int NBI = (BN * 8) / 256;
  static_assert((BN * 8) % 256 == 0, "BN");
  const int tid = opaque_tid(), lane = tid & 63, w = tid >> 6, l15 = lane & 15, quad = lane >> 4;
  const int wm = w >> 1, wn = w & 1;
  const u16* ap[4];
  const u16* bp[NBI];
#pragma unroll
  for (int i = 0; i < 4; i++) {
    int c = tid + i * 256;
    ap[i] = arow(c >> 3) + (c & 7) * 8;
  }
#pragma unroll
  for (int i = 0; i < NBI; i++) {
    int c = tid + i * 256;
    bp[i] = brow(c >> 3) + (c & 7) * 8;
  }
  const int srow = tid >> 3;
  const int soff = srow * 64 + (((tid & 7) ^ ((srow >> 1) & 7)) * 8);
  const int swz = (l15 >> 1) & 7;
  u32x4 r0a[4], r0b[NBI], r1a[4], r1b[NBI];
#pragma unroll
  for (int i = 0; i < 4; i++)
#pragma unroll
    for (int j = 0; j < NF; j++) acc[i][j] = f32x4{0.f, 0.f, 0.f, 0.f};

#define GLOAD(RA, RB, KT)                                                              \
  {                                                                                    \
    _Pragma("unroll") for (int i = 0; i < 4; i++) RA[i] = *(const u32x4*)(ap[i] + (KT) * 64);   \
    _Pragma("unroll") for (int i = 0; i < NBI; i++) RB[i] = *(const u32x4*)(bp[i] + (KT) * 64); \
  }
#define SSTORE(RA, RB, ST)                                                             \
  {                                                                                    \
    u16* A_ = lds + (ST) * STAGE;                                                      \
    u16* B_ = A_ + 128 * 64;                                                           \
    _Pragma("unroll") for (int i = 0; i < 4; i++) *(u32x4*)(A_ + soff + i * 32 * 64) = RA[i];   \
    _Pragma("unroll") for (int i = 0; i < NBI; i++) *(u32x4*)(B_ + soff + i * 32 * 64) = RB[i]; \
  }
#define LFRAGS(ST)                                                                     \
    const u16* A_ = lds + (ST) * STAGE;                                                \
    const u16* B_ = A_ + 128 * 64;                                                     \
    bf16x8 af[2][4], bfr[2][NF];                                                       \
    _Pragma("unroll") for (int ks = 0; ks < 2; ks++) {                                 \
      const int co = (((ks * 4 + quad) ^ swz) * 8);                                    \
      _Pragma("unroll") for (int i = 0; i < 4; i++) af[ks][i] = *(const bf16x8*)(A_ + (wm * 64 + i * 16 + l15) * 64 + co);          \
      _Pragma("unroll") for (int j = 0; j < NF; j++) bfr[ks][j] = *(const bf16x8*)(B_ + (wn * (BN / 2) + j * 16 + l15) * 64 + co);  \
    }
#define MFMAS(KS)                                                                      \
    _Pragma("unroll") for (int i = 0; i < 4; i++)                                      \
      _Pragma("unroll") for (int j = 0; j < NF; j++)                                   \
        acc[i][j] = __builtin_amdgcn_mfma_f32_16x16x32_bf16(af[KS][i], bfr[KS][j], acc[i][j], 0, 0, 0);

  __syncthreads();
  GLOAD(r0a, r0b, 0);
  if (nk > 1) GLOAD(r1a, r1b, 1);
  SSTORE(r0a, r0b, 0);
  __syncthreads();
  for (int kt = 0; kt < nk; kt += 2) {
    {
      if (kt + 2 < nk) GLOAD(r0a, r0b, kt + 2);
      LFRAGS(0);
      __builtin_amdgcn_sched_barrier(0);
      __builtin_amdgcn_s_setprio(1);
      MFMAS(0);
      __builtin_amdgcn_sched_barrier(0);
      if (kt + 1 < nk) SSTORE(r1a, r1b, 1);
      __builtin_amdgcn_sched_barrier(0);
      MFMAS(1);
      __builtin_amdgcn_s_setprio(0);
      __syncthreads();
    }
    if (kt + 1 >= nk) break;
    {
      if (kt + 3 < nk) GLOAD(r1a, r1b, kt + 3);
      LFRAGS(1);
      __builtin_amdgcn_sched_barrier(0);
      __builtin_amdgcn_s_setprio(1);
      MFMAS(0);
      __builtin_amdgcn_sched_barrier(0);
      if (kt + 2 < nk) SSTORE(r0a, r0b, 0);
      __builtin_amdgcn_sched_barrier(0);
      MFMAS(1);
      __builtin_amdgcn_s_setprio(0);
      __syncthreads();
    }
  }
#undef GLOAD
#undef SSTORE
#undef LFRAGS
#undef MFMAS
}

template <int BN, class AF1, class BF1, class AF2, class BF2>
DEV void gemm_dual(AF1 arow1, BF1 brow1, int nk1, f32x4 (&acc1)[4][BN / 32], AF2 arow2, BF2 brow2, int nk2,
                   f32x4 (&acc2)[4][BN / 32], u16* lds) {
  constexpr int NF = BN / 32;
  constexpr int STAGE = (128 + BN) * 64;
  constexpr int NBI = (BN * 8) / 256;
  const int tid = opaque_tid(), lane = tid & 63, w = tid >> 6, l15 = lane & 15, quad = lane >> 4;
  const int wm = w >> 1, wn = w & 1;
  const int nk = nk1 + nk2;
  const u16* ap1[4]; const u16* bp1[NBI]; const u16* ap2[4]; const u16* bp2[NBI];
#pragma unroll
  for (int i = 0; i < 4; i++) {
    int c = tid + i * 256;
    ap1[i] = arow1(c >> 3) + (c & 7) * 8;
    ap2[i] = arow2(c >> 3) + (c & 7) * 8 - (size_t)nk1 * 64;
  }
#pragma unroll
  for (int i = 0; i < NBI; i++) {
    int c = tid + i * 256;
    bp1[i] = brow1(c >> 3) + (c & 7) * 8;
    bp2[i] = brow2(c >> 3) + (c & 7) * 8 - (size_t)nk1 * 64;
  }
  const int srow = tid >> 3;
  const int soff = srow * 64 + (((tid & 7) ^ ((srow >> 1) & 7)) * 8);
  const int swz = (l15 >> 1) & 7;
  u32x4 r0a[4], r0b[NBI], r1a[4], r1b[NBI];
#pragma unroll
  for (int i = 0; i < 4; i++)
#pragma unroll
    for (int j = 0; j < NF; j++) { acc1[i][j] = f32x4{0.f, 0.f, 0.f, 0.f}; acc2[i][j] = f32x4{0.f, 0.f, 0.f, 0.f}; }

#define GLOAD(RA, RB, KT)                                                              \
  {                                                                                    \
    const bool s2_ = (KT) >= nk1;                                                      \
    _Pragma("unroll") for (int i = 0; i < 4; i++) RA[i] = *(const u32x4*)((s2_ ? ap2[i] : ap1[i]) + (KT) * 64);   \
    _Pragma("unroll") for (int i = 0; i < NBI; i++) RB[i] = *(const u32x4*)((s2_ ? bp2[i] : bp1[i]) + (KT) * 64); \
  }
#define SSTORE(RA, RB, ST)                                                             \
  {                                                                                    \
    u16* A_ = lds + (ST) * STAGE;                                                      \
    u16* B_ = A_ + 128 * 64;                                                           \
    _Pragma("unroll") for (int i = 0; i < 4; i++) *(u32x4*)(A_ + soff + i * 32 * 64) = RA[i];   \
    _Pragma("unroll") for (int i = 0; i < NBI; i++) *(u32x4*)(B_ + soff + i * 32 * 64) = RB[i]; \
  }
#define LFRAGS(ST)                                                                     \
    const u16* A_ = lds + (ST) * STAGE;                                                \
    const u16* B_ = A_ + 128 * 64;                                                     \
    bf16x8 af[2][4], bfr[2][NF];                                                       \
    _Pragma("unroll") for (int ks = 0; ks < 2; ks++) {                                 \
      const int co = (((ks * 4 + quad) ^ swz) * 8);                                    \
      _Pragma("unroll") for (int i = 0; i < 4; i++) af[ks][i] = *(const bf16x8*)(A_ + (wm * 64 + i * 16 + l15) * 64 + co);          \
      _Pragma("unroll") for (int j = 0; j < NF; j++) bfr[ks][j] = *(const bf16x8*)(B_ + (wn * (BN / 2) + j * 16 + l15) * 64 + co);  \
    }
#define MFMAS(ACC, KS)                                                                 \
    _Pragma("unroll") for (int i = 0; i < 4; i++)                                      \
      _Pragma("unroll") for (int j = 0; j < NF; j++)                                   \
        ACC[i][j] = __builtin_amdgcn_mfma_f32_16x16x32_bf16(af[KS][i], bfr[KS][j], ACC[i][j], 0, 0, 0);
#define STEP_PAIR(ACC)                                                                 \
    {                                                                                  \
      if (kt + 2 < nk) GLOAD(r0a, r0b, kt + 2);                                        \
      LFRAGS(0);                                                                       \
      __builtin_amdgcn_sched_barrier(0);                                               \
      MFMAS(ACC, 0);                                                                   \
      __builtin_amdgcn_sched_barrier(0);                                               \
      SSTORE(r1a, r1b, 1);                                                             \
      __builtin_amdgcn_sched_barrier(0);                                               \
      MFMAS(ACC, 1);                                                                   \
      __syncthreads();                                                                 \
    }                                                                                  \
    {                                                                                  \
      if (kt + 3 < nk) GLOAD(r1a, r1b, kt + 3);                                        \
      LFRAGS(1);                                                                       \
      __builtin_amdgcn_sched_barrier(0);                                               \
      MFMAS(ACC, 0);                                                                   \
      __builtin_amdgcn_sched_barrier(0);                                               \
      if (kt + 2 < nk) SSTORE(r0a, r0b, 0);                                            \
      __builtin_amdgcn_sched_barrier(0);                                               \
      MFMAS(ACC, 1);                                                                   \
      __syncthreads();                                                                 \
    }

  __syncthreads();
  GLOAD(r0a, r0b, 0);
  GLOAD(r1a, r1b, 1);
  SSTORE(r0a, r0b, 0);
  __syncthreads();
  for (int kt = 0; kt < nk1; kt += 2) { STEP_PAIR(acc1) }
  for (int kt = nk1; kt < nk; kt += 2) { STEP_PAIR(acc2) }
#undef GLOAD
#undef SSTORE
#undef LFRAGS
#undef MFMAS
#undef STEP_PAIR
}

template <class AF, class BF>
DEV void gemm_wide(AF arow, BF brow, int nk, f32x4 (&acc)[4][8], u16* lds) {
  constexpr int STAGE = (128 + 256) * 32;
  const int tid = opaque_tid(), lane = tid & 63, w = tid >> 6, l15 = lane & 15, quad = lane >> 4;
  const int wm = w >> 1, wn = w & 1;
  const u16* ap[2];
  const u16* bp[4];
#pragma unroll
  for (int i = 0; i < 2; i++) {
    int c = tid + i * 256;
    ap[i] = arow(c >> 2) + (c & 3) * 8;
  }
#pragma unroll
  for (int i = 0; i < 4; i++) {
    int c = tid + i * 256;
    bp[i] = brow(c >> 2) + (c & 3) * 8;
  }
  u32x4 ra[2], rb[4];
#pragma unroll
  for (int i = 0; i < 4; i++)
#pragma unroll
    for (int j = 0; j < 8; j++) acc[i][j] = f32x4{0.f, 0.f, 0.f, 0.f};
  __syncthreads();
#pragma unroll
  for (int i = 0; i < 2; i++) ra[i] = *(const u32x4*)(ap[i]);
#pragma unroll
  for (int i = 0; i < 4; i++) rb[i] = *(const u32x4*)(bp[i]);
  {
    u16* A_ = lds;
    u16* B_ = A_ + 128 * 32;
#pragma unroll
    for (int i = 0; i < 2; i++) *(u32x4*)(A_ + (tid + i * 256) * 8) = ra[i];
#pragma unroll
    for (int i = 0; i < 4; i++) *(u32x4*)(B_ + (tid + i * 256) * 8) = rb[i];
  }
  __syncthreads();
  for (int kt = 0; kt < nk; kt++) {
    const bool more = (kt + 1 < nk);
    if (more) {
#pragma unroll
      for (int i = 0; i < 2; i++) ra[i] = *(const u32x4*)(ap[i] + (kt + 1) * 32);
#pragma unroll
      for (int i = 0; i < 4; i++) rb[i] = *(const u32x4*)(bp[i] + (kt + 1) * 32);
    }
    const u16* A_ = lds + (kt & 1) * STAGE;
    const u16* B_ = A_ + 128 * 32;
    bf16x8 af[4], bfr[8];
#pragma unroll
    for (int i = 0; i < 4; i++) af[i] = *(const bf16x8*)(A_ + (wm * 64 + i * 16 + l15) * 32 + quad * 8);
#pragma unroll
    for (int j = 0; j < 8; j++) bfr[j] = *(const bf16x8*)(B_ + (wn * 128 + j * 16 + l15) * 32 + quad * 8);
    __builtin_amdgcn_sched_barrier(0);
    __builtin_amdgcn_s_setprio(3);
#pragma unroll
    for (int j = 0; j < 4; j++)
#pragma unroll
      for (int i = 0; i < 4; i++) acc[i][j] = __builtin_amdgcn_mfma_f32_16x16x32_bf16(af[i], bfr[j], acc[i][j], 0, 0, 0);
    __builtin_amdgcn_sched_barrier(0);
    if (more) {
      u16* A2 = lds + ((kt + 1) & 1) * STAGE;
      u16* B2 = A2 + 128 * 32;
#pragma unroll
      for (int i = 0; i < 2; i++) *(u32x4*)(A2 + (tid + i * 256) * 8) = ra[i];
#pragma unroll
      for (int i = 0; i < 4; i++) *(u32x4*)(B2 + (tid + i * 256) * 8) = rb[i];
    }
    __builtin_amdgcn_sched_barrier(0);
#pragma unroll
    for (int j = 4; j < 8; j++)
#pragma unroll
      for (int i = 0; i < 4; i++) acc[i][j] = __builtin_amdgcn_mfma_f32_16x16x32_bf16(af[i], bfr[j], acc[i][j], 0, 0, 0);
    __builtin_amdgcn_s_setprio(0);
    __syncthreads();
  }
}
#define ACC_COLW(j) (wn * 128 + (j) * 16 + l15)

#define ACC_ROW(i, e) (wm * 64 + (i) * 16 + quad * 4 + (e))
#define ACC_COL(BN, j) (wn * ((BN) / 2) + (j) * 16 + l15)

template <int BN>
DEV void acc_to_lds(f32x4 (&acc)[4][BN / 32], float* st) {
  const int tid = opaque_tid(), lane = tid & 63, w = tid >> 6, l15 = lane & 15, quad = lane >> 4;
  const int wm = w >> 1, wn = w & 1;
#pragma unroll
  for (int i = 0; i < 4; i++)
#pragma unroll
    for (int j = 0; j < BN / 32; j++)
#pragma unroll
      for (int e = 0; e < 4; e++) st[ACC_ROW(i, e) * (BN + 1) + ACC_COL(BN, j)] = acc[i][j][e];
}

template <int DQ, bool NA>
DEV void attn_item(const u16* __restrict__ Qb, const u16* __restrict__ Kb, const u16* __restrict__ Vt, int q0, int t0,
                   int n0, int t1, int n1, float sc2, float mref2, u16* __restrict__ Op, int r0, const float* __restrict__ rpbh,
                   u16* lds, float* rpb_lds) {
  constexpr int NDC = DQ / 32;
  constexpr int KT = 64 * DQ, VT = 64 * 64, STAGE = KT + VT;
#define KOFF(row, kc) (((kc) < 8) ? ((row) * 64 + ((((kc) ^ (((row) >> 1) & 7))) * 8)) : (4096 + (row) * 32 + ((kc) - 8) * 8))
#define VOFF(dv, kc) ((dv) * 64 + ((((kc) ^ (((dv) >> 1) & 7))) * 8))
  constexpr int CPR = DQ / 8;
  constexpr int NKI = (64 * CPR) / 256;
  const int tid = opaque_tid(), lane = tid & 63, w = tid >> 6, l15 = lane & 15, quad = lane >> 4;
  __syncthreads();
  if (NA) {
    for (int i = tid; i < 465; i += 256) rpb_lds[i] = rpbh[i] * (LOG2E / sc2);
  }
  bf16x8 qf[2][NDC];
#pragma unroll
  for (int qg = 0; qg < 2; qg++)
#pragma unroll
    for (int dc = 0; dc < NDC; dc++)
      qf[qg][dc] = *(const bf16x8*)(Qb + (size_t)(q0 + w * 32 + qg * 16 + l15) * DQ + dc * 32 + quad * 8);
  u32x4 rk[NKI], rv[2];
  const int nt = n0 + n1;
  f32x4 o[4][2];
#pragma unroll
  for (int dg = 0; dg < 4; dg++)
#pragma unroll
    for (int qg = 0; qg < 2; qg++) o[dg][qg] = f32x4{0.f, 0.f, 0.f, 0.f};
  float lrun[2] = {0.f, 0.f};
  f32x4 zero4 = f32x4{0.f, 0.f, 0.f, 0.f};
  asm volatile("" : "+v"(zero4));

  {
    const int t = (0 < n0) ? t0 : t1;
#pragma unroll
    for (int i = 0; i < NKI; i++) {
      int c = tid + i * 256;
      int row = c / CPR, kc = c % CPR;
      rk[i] = *(const u32x4*)(Kb + (size_t)t * (64 * DQ) + (unsigned)(row * DQ + kc * 8));
    }
#pragma unroll
    for (int i = 0; i < 2; i++) {
      int c = tid + i * 256;
      int dv = c >> 3, kc = c & 7;
      rv[i] = *(const u32x4*)(Vt + (size_t)t * 64 + (unsigned)(dv * SS + kc * 8));
    }
    u16* Ks = lds;
    u16* Vs = Ks + KT;
#pragma unroll
    for (int i = 0; i < NKI; i++) {
      int c = tid + i * 256;
      int row = c / CPR, kc = c % CPR;
      *(u32x4*)(Ks + KOFF(row, kc)) = rk[i];
    }
#pragma unroll
    for (int i = 0; i < 2; i++) {
      int c = tid + i * 256;
      int dv = c >> 3, kc = c & 7;
      *(u32x4*)(Vs + VOFF(dv, kc)) = rv[i];
    }
  }
  __syncthreads();
  for (int it = 0; it < nt; it++) {
    const bool more = (it + 1 < nt);
    if (more) {
      const int t = (it + 1 < n0) ? (t0 + it + 1) : (t1 + it + 1 - n0);
#pragma unroll
      for (int i = 0; i < NKI; i++) {
        int c = tid + i * 256;
        int row = c / CPR, kc = c % CPR;
        rk[i] = *(const u32x4*)(Kb + (size_t)t * (64 * DQ) + (unsigned)(row * DQ + kc * 8));
      }
#pragma unroll
      for (int i = 0; i < 2; i++) {
        int c = tid + i * 256;
        int dv = c >> 3, kc = c & 7;
        rv[i] = *(const u32x4*)(Vt + (size_t)t * 64 + (unsigned)(dv * SS + kc * 8));
      }
    }
    const u16* Ks = lds + (it & 1) * STAGE;
    const u16* Vs = Ks + KT;
    f32x4 s[4][2];
    {
      bf16x8 kf[NDC][4];
#pragma unroll
      for (int dc = 0; dc < NDC; dc++)
#pragma unroll
        for (int kg = 0; kg < 4; kg++) kf[dc][kg] = *(const bf16x8*)(Ks + KOFF(kg * 16 + l15, dc * 4 + quad));
#pragma unroll
      for (int kg = 0; kg < 4; kg++)
#pragma unroll
        for (int qg = 0; qg < 2; qg++) s[kg][qg] = __builtin_amdgcn_mfma_f32_16x16x32_bf16(kf[0][kg], qf[qg][0], zero4, 0, 0, 0);
#pragma unroll
      for (int dc = 1; dc < NDC; dc++)
#pragma unroll
        for (int kg = 0; kg < 4; kg++)
#pragma unroll
          for (int qg = 0; qg < 2; qg++) s[kg][qg] = __builtin_amdgcn_mfma_f32_16x16x32_bf16(kf[dc][kg], qf[qg][dc], s[kg][qg], 0, 0, 0);
    }
    bf16x8 vf[2][4];
#pragma unroll
    for (int t2 = 0; t2 < 2; t2++)
#pragma unroll
      for (int dg = 0; dg < 4; dg++) vf[t2][dg] = *(const bf16x8*)(Vs + VOFF(dg * 16 + l15, t2 * 4 + quad));
    if (NA) {
      const bool band = (it >= n0);
      if (band) {
        const int kr = t1 + (it - n0) - 4;
        const int r = r0 + (w >> 1);
        const int rs = clampi(r - 4, 0, 120);
        const bool rowok = (kr >= rs) && (kr < rs + 8);
#pragma unroll
        for (int qg = 0; qg < 2; qg++) {
          const int qc = (w & 1) * 32 + qg * 16 + l15;
          const int cs = clampi(qc - 8, 0, 48);
#pragma unroll
          for (int kg = 0; kg < 4; kg++)
#pragma unroll
            for (int e = 0; e < 4; e++) {
              const int kc = kg * 16 + quad * 4 + e;
              const bool ok = rowok && (kc >= cs) && (kc < cs + 16);
              int bi = (kr - r + 7) * 31 + (kc - qc + 15);
              bi = ok ? bi : 0;
              s[kg][qg][e] = ok ? (s[kg][qg][e] + rpb_lds[bi]) : -1e30f;
            }
        }
      }
    }
#pragma unroll
    for (int qg = 0; qg < 2; qg++) {
      float ps = 0.f;
#pragma unroll
      for (int kg = 0; kg < 4; kg++)
#pragma unroll
        for (int e = 0; e < 4; e++) {
          float pv = __builtin_amdgcn_exp2f(fmaf(s[kg][qg][e], sc2, -mref2));
          s[kg][qg][e] = pv;
          ps += pv;
        }
      lrun[qg] += ps;
    }
#pragma unroll
    for (int t2 = 0; t2 < 2; t2++) {
      bf16x8 pb[2];
#pragma unroll
      for (int qg = 0; qg < 2; qg++) {
        u32x4 cv;
        cv[0] = pack2(s[2 * t2][qg][0], s[2 * t2][qg][1]);
        cv[1] = pack2(s[2 * t2][qg][2], s[2 * t2][qg][3]);
        cv[2] = pack2(s[2 * t2 + 1][qg][0], s[2 * t2 + 1][qg][1]);
        cv[3] = pack2(s[2 * t2 + 1][qg][2], s[2 * t2 + 1][qg][3]);
        pb[qg] = __builtin_bit_cast(bf16x8, cv);
      }
#pragma unroll
      for (int dg = 0; dg < 4; dg++) {
#pragma unroll
        for (int qg = 0; qg < 2; qg++) o[dg][qg] = __builtin_amdgcn_mfma_f32_16x16x32_bf16(vf[t2][dg], pb[qg], o[dg][qg], 0, 0, 0);
      }
    }
    if (more) {
      u16* K2 = lds + ((it + 1) & 1) * STAGE;
      u16* V2 = K2 + KT;
#pragma unroll
      for (int i = 0; i < NKI; i++) {
        int c = tid + i * 256;
        int row = c / CPR, kc = c % CPR;
        *(u32x4*)(K2 + KOFF(row, kc)) = rk[i];
      }
#pragma unroll
      for (int i = 0; i < 2; i++) {
        int c = tid + i * 256;
        int dv = c >> 3, kc = c & 7;
        *(u32x4*)(V2 + VOFF(dv, kc)) = rv[i];
      }
    }
    __syncthreads();
  }
#pragma unroll
  for (int qg = 0; qg < 2; qg++) {
    float l = lrun[qg];
    l += shfl_xor_f(l, 16);
    l += shfl_xor_f(l, 32);
    const float inv = 1.f / l;
    u16* dst = Op + (size_t)(w * 32 + qg * 16 + l15) * 1024 + quad * 4;
#pragma unroll
    for (int dg = 0; dg < 4; dg++) {
      uint2 v;
      v.x = pack2(o[dg][qg][0] * inv, o[dg][qg][1] * inv);
      v.y = pack2(o[dg][qg][2] * inv, o[dg][qg][3] * inv);
      *(uint2*)(dst + dg * 16) = v;
    }
  }
}
#undef KOFF
#undef VOFF

DEV void conv_tile(const float* __restrict__ src, int K, int N, u16* __restrict__ dst, int kt, int nt, float* lds, const float* __restrict__ kscale) {
  const int tid = opaque_tid();
  __syncthreads();
  {
    float4 v[4];
    const int n4 = (tid & 15) * 4;
    const int gn = nt * 64 + n4;
#pragma unroll
    for (int i = 0; i < 4; i++) {
      const int k = i * 16 + (tid >> 4);
      v[i] = (gn < N) ? *(const float4*)(src + (size_t)(kt * 64 + k) * N + gn) : make_float4(0.f, 0.f, 0.f, 0.f);
      if (kscale) { const float ks = kscale[kt * 64 + k]; v[i].x *= ks; v[i].y *= ks; v[i].z *= ks; v[i].w *= ks; }
    }
#pragma unroll
    for (int i = 0; i < 4; i++) {
      const int k = i * 16 + (tid >> 4);
      float* d = lds + k * 65 + n4;
      d[0] = v[i].x; d[1] = v[i].y; d[2] = v[i].z; d[3] = v[i].w;
    }
  }
  __syncthreads();
#pragma unroll
  for (int i = 0; i < 2; i++) {
    const int c = tid + i * 256;
    const int nn = c >> 3, k8 = (c & 7) * 8;
    float f[8];
#pragma unroll
    for (int e = 0; e < 8; e++) f[e] = lds[(k8 + e) * 65 + nn];
    store8(dst + (size_t)(nt * 64 + nn) * K + kt * 64 + k8, f);
  }
}

constexpr int NCT = 4272;

DEV void phase0(const Params& p, int vb, int G, char* smem) {
  float* ldsf = (float*)smem;
  const int tid = opaque_tid();
  const int total = 2 * NCT + 128 + 192 + 1;
  for (int it0 = vb; it0 < total; it0 += G) {
    const int it = (it0 < 192) ? (2 * NCT + 128 + it0) : ((it0 < 192 + 2 * NCT + 128) ? (it0 - 192) : it0);
    if (it < 2 * NCT) {
      const int l = it / NCT;
      int idx = it - l * NCT;
      u16* W = (u16*)(p.ws + WS_W) + (size_t)l * WL;
      const float* src; u16* dst; int K, N, kt, nt; const float* kscale = nullptr;
      if (idx < 576) { K = 1024; N = 2272; nt = idx >> 4; kt = idx & 15; src = p.in[6] + (size_t)l * 1024 * 2272; dst = W + OW_IN; }
      else if ((idx -= 576) < 1024) { int i = idx >> 8, r = idx & 255; K = 1024; N = 1024; nt = r >> 4; kt = r & 15; src = p.in[22] + (size_t)(l * 4 + i) * 1048576; dst = W + OW_GATE + (size_t)i * 1048576; }
      else if ((idx -= 1024) < 256) { int i = idx >> 6, r = idx & 63; K = 256; N = 1024; nt = r >> 2; kt = r & 3; src = p.in[21] + (size_t)(l * 4 + i) * 262144; dst = W + OW_BRANCH + (size_t)i * 262144; }
      else if ((idx -= 256) < 256) { K = 1024; N = 1024; nt = idx >> 4; kt = idx & 15; src = p.in[24] + (size_t)l * 1048576; dst = W + OW_OUT; }
      else if ((idx -= 256) < 1408) { K = 1024; N = 5632; nt = idx >> 4; kt = idx & 15; src = p.in[25] + (size_t)l * 1024 * 5632; dst = W + OW_UP; }
      else if ((idx -= 1408) < 704) { K = 2816; N = 1024; nt = idx / 44; kt = idx % 44; src = p.in[28] + (size_t)l * 2816 * 1024; dst = W + OW_DOWN; }
      else if ((idx -= 704) < 24) { K = 256; N = 384; nt = idx >> 2; kt = idx & 3; src = p.in[12] + (size_t)l * 256 * 384; dst = W + OW_UQ; kscale = p.in[10] + l * 256; }
      else { idx -= 24; K = 192; N = 512; nt = idx / 3; kt = idx % 3; src = p.in[13] + (size_t)l * 192 * 512; dst = W + OW_UKV; kscale = p.in[11] + l * 192; }
      conv_tile(src, K, N, dst, kt, nt, ldsf, kscale);
    } else if (it < 2 * NCT + 128) {
      const int j = it - 2 * NCT;
      const int l = j >> 6, ch = j & 63;
      const float* src = p.in[17] + (size_t)l * 65536 + ch * 1024;
      u16* dst = (u16*)(p.ws + WS_W) + (size_t)l * WL + OW_SG + ch * 1024;
      float4 v = *(const float4*)(src + tid * 4);
      uint2 o; o.x = pack2(v.x, v.y); o.y = pack2(v.z, v.w);
      *(uint2*)(dst + tid * 4) = o;
    } else if (it < 2 * NCT + 128 + 192) {
      const int j = it - (2 * NCT + 128);
      const int l = j / 96, cb = j % 96;
      __syncthreads();
      float* sc = ldsf;
      float* red = ldsf + 5120;
      for (int i = tid; i < 5120; i += 256) {
        int m = i >> 10, k = i & 1023;
        float c = (m < 4) ? p.in[1][m * 1024 + k] : p.in[3][k];
        sc[i] = silu_f(c);
      }
      __syncthreads();
      const int kg = tid >> 6, n = tid & 63;
      const float* wsrc = p.in[4] + (size_t)l * 1024 * 6144 + cb * 64 + n;
      float a0 = 0, a1 = 0, a2 = 0, a3 = 0, a4 = 0;
#pragma unroll 8
      for (int k = kg * 256; k < kg * 256 + 256; k++) {
        float wv = wsrc[(size_t)k * 6144];
        a0 += sc[k] * wv; a1 += sc[1024 + k] * wv; a2 += sc[2048 + k] * wv; a3 += sc[3072 + k] * wv; a4 += sc[4096 + k] * wv;
      }
      red[(kg * 5 + 0) * 64 + n] = a0; red[(kg * 5 + 1) * 64 + n] = a1; red[(kg * 5 + 2) * 64 + n] = a2;
      red[(kg * 5 + 3) * 64 + n] = a3; red[(kg * 5 + 4) * 64 + n] = a4;
      __syncthreads();
      for (int i = tid; i < 320; i += 256) {
        int m = i >> 6, nn = i & 63;
        float v = red[(0 * 5 + m) * 64 + nn] + red[(1 * 5 + m) * 64 + nn] + red[(2 * 5 + m) * 64 + nn] + red[(3 * 5 + m) * 64 + nn];
        v += p.in[5][(size_t)l * 6144 + cb * 64 + nn];
        ((float*)(p.ws + WS_MOD))[(size_t)(l * 5 + m) * 6144 + cb * 64 + nn] = v;
      }
    } else {
      float2* r16 = (float2*)(p.ws + WS_R16);
      float2* r8 = (float2*)(p.ws + WS_R8);
      for (int i = tid; i < 1024; i += 256) ((unsigned*)(p.ws + WS_ZROW))[i] = 0u;
      for (int i = tid; i < 2048; i += 256) {
        int pos = i >> 4, k = i & 15;
        float inv = powf(10000.f, -(float)k / 16.f);
        float ang = (float)pos * inv;
        r16[i] = make_float2(cosf(ang), sinf(ang));
      }
      for (int i = tid; i < 1024; i += 256) {
        int pos = i >> 3, k = i & 7;
        float inv = powf(10000.f, -(float)k / 8.f);
        float ang = (float)pos * inv;
        r8[i] = make_float2(cosf(ang), sinf(ang));
      }
    }
  }
}

DEV void phase_modulate(const XMap& xin, const float* __restrict__ modl, int shi, int sci, u16* __restrict__ H,
                        bool skip_ctx, int vb, int G) {
  const int tid = opaque_tid(), lane = tid & 63, w = tid >> 6;
  for (int m = vb * 4 + w; m < MM; m += G * 4) {
    const int b = m / SS, s = m - b * SS;
    if (skip_ctx && s < CC) continue;
    const int mrow = (s < CC) ? 4 : b;
    const float* xr = xrow(xin, m);
    float4 v[4];
    float ss = 0.f;
#pragma unroll
    for (int i = 0; i < 4; i++) {
      v[i] = *(const float4*)(xr + i * 256 + lane * 4);
      ss += v[i].x * v[i].x + v[i].y * v[i].y + v[i].z * v[i].z + v[i].w * v[i].w;
    }
#pragma unroll
    for (int o = 32; o >= 1; o >>= 1) ss += shfl_xor_f(ss, o);
    const float rstd = rsqrtf(ss * (1.f / 1024.f) + EPS);
    const float* sh = modl + (size_t)mrow * 6144 + shi * 1024;
    const float* sc = modl + (size_t)mrow * 6144 + sci * 1024;
#pragma unroll
    for (int i = 0; i < 4; i++) {
      const int n = i * 256 + lane * 4;
      float4 a = *(const float4*)(sc + n);
      float4 c = *(const float4*)(sh + n);
      uint2 o;
      o.x = pack2(v[i].x * rstd * (1.f + a.x) + c.x, v[i].y * rstd * (1.f + a.y) + c.y);
      o.y = pack2(v[i].z * rstd * (1.f + a.z) + c.z, v[i].w * rstd * (1.f + a.w) + c.w);
      *(uint2*)(H + (size_t)m * DD + n) = o;
    }
  }
}

DEV void unpack8(const u32x4& v, float (&f)[8]) {
  f[0] = __uint_as_float(v[0] << 16); f[1] = __uint_as_float(v[0] & 0xffff0000u);
  f[2] = __uint_as_float(v[1] << 16); f[3] = __uint_as_float(v[1] & 0xffff0000u);
  f[4] = __uint_as_float(v[2] << 16); f[5] = __uint_as_float(v[2] & 0xffff0000u);
  f[6] = __uint_as_float(v[3] << 16); f[7] = __uint_as_float(v[3] & 0xffff0000u);
}

DEV void head_norm64(float (&v)[8], const float* __restrict__ gain, int c, bool rope, int s, const float2* __restrict__ R16) {
  float ss = 0.f;
#pragma unroll
  for (int e = 0; e < 8; e++) ss += v[e] * v[e];
  ss += shfl_xor_f(ss, 1); ss += shfl_xor_f(ss, 2); ss += shfl_xor_f(ss, 4);
  const float rstd = rsqrtf(ss * (1.f / 64.f) + EPS);
#pragma unroll
  for (int e = 0; e < 8; e++) v[e] *= rstd * gain[c * 8 + e];
  if (rope) {
    const int tl = s - CC;
    const int pos = (c & 4) ? (tl & 63) : (tl >> 6);
#pragma unroll
    for (int e = 0; e < 8; e++) {
      float pr = shfl_xor_f(v[e], 2);
      float2 cs = R16[pos * 16 + (c & 1) * 8 + e];
      v[e] = (c & 2) ? (v[e] * cs.x + pr * cs.y) : (v[e] * cs.x - pr * cs.y);
    }
  }
}

DEV void prep_item(const Params& p, int l, int it, char* smem) {
  u16* Z = (u16*)(p.ws + WS_Z);
  u16* QKV = (u16*)(p.ws + WS_QKV);
  const float2* R16 = (const float2*)(p.ws + WS_R16);
  const float2* R8 = (const float2*)(p.ws + WS_R8);
  float* rstd_l = (float*)smem;
  const float* na_qn = p.in[7] + l * 64;
  const float* na_kn = p.in[8] + l * 64;
  const float* cq_n = p.in[10] + l * 256;
  const float* ckv_n = p.in[11] + l * 192;
  const float* mla_kn = p.in[15] + l * 96;
  const float* sgv_n = p.in[16] + l * 256;
  const float* gq_qn = p.in[19] + l * 64;
  const float* gq_kn = p.in[20] + l * 64;
  {
    const int tid = opaque_tid(), lane = tid & 63, w = tid >> 6;
    const int part = it % 3;
    const int m0 = (it / 3) * 64;
    const int b = m0 / SS, s0 = m0 - b * SS;
    const bool latent = (s0 >= CC);
    if (part == 0) {
      const int c = tid & 7;
#pragma unroll
      for (int g = 0; g < 2; g++) {
        u32x4 raw[4][2];
#pragma unroll
        for (int h = 0; h < 4; h++)
#pragma unroll
          for (int rep = 0; rep < 2; rep++)
            raw[h][rep] = *(const u32x4*)(Z + (size_t)(m0 + rep * 32 + (tid >> 3)) * ZW + g * 256 + h * 64 + c * 8);
        const float* gain = g ? na_kn : na_qn;
#pragma unroll
        for (int h = 0; h < 4; h++)
#pragma unroll
          for (int rep = 0; rep < 2; rep++) {
            const int s = s0 + rep * 32 + (tid >> 3);
            float v[8];
            unpack8(raw[h][rep], v);
            head_norm64(v, gain, c, false, s, R16);
            store8(QKV + (g ? K_NA : Q_NA) + ((size_t)(b * 4 + h) * SS + s) * 64 + c * 8, v);
          }
      }
    } else if (part == 1) {
      const int c = tid & 7;
      {
        u32x4 raw[6][2];
#pragma unroll
        for (int h = 0; h < 6; h++)
#pragma unroll
          for (int rep = 0; rep < 2; rep++)
            raw[h][rep] = *(const u32x4*)(Z + (size_t)(m0 + rep * 32 + (tid >> 3)) * ZW + 1760 + h * 64 + c * 8);
#pragma unroll
        for (int h = 0; h < 6; h++)
#pragma unroll
          for (int rep = 0; rep < 2; rep++) {
            const int s = s0 + rep * 32 + (tid >> 3);
            float v[8];
            unpack8(raw[h][rep], v);
            head_norm64(v, (h < 4) ? gq_qn : gq_kn, c, latent, s, R16);
            u16* dst = (h < 4) ? (QKV + Q_GQA + ((size_t)(b * 4 + h) * SS + s) * 64) : (QKV + K_GQA + ((size_t)(b * 2 + (h - 4)) * SS + s) * 64);
            store8(dst + c * 8, v);
          }
      }
      const int sp = perm32(s0 + lane);
#pragma unroll
      for (int k3 = 0; k3 < 3; k3++) {
        u32x4 raw[4];
#pragma unroll
        for (int q = 0; q < 4; q++) {
          const int ct = w + 4 * (k3 * 4 + q);
          const int srccol = (ct < 32) ? (512 + ct * 8) : (2144 + (ct - 32) * 8);
          raw[q] = *(const u32x4*)(Z + (size_t)(m0 + lane) * ZW + srccol);
        }
#pragma unroll
        for (int q = 0; q < 4; q++) {
          const int ct = w + 4 * (k3 * 4 + q);
          u16* dst;
          if (ct < 32) { int head = ct >> 3, dv0 = (ct & 7) * 8; dst = QKV + V_NA + ((size_t)(b * 4 + head) * 64 + dv0) * SS; }
          else { int cg2 = ct - 32; int head = cg2 >> 3, dv0 = (cg2 & 7) * 8; dst = QKV + V_GQA + ((size_t)(b * 2 + head) * 64 + dv0) * SS; }
          dst += sp;
#pragma unroll
          for (int e = 0; e < 4; e++) {
            dst[(size_t)(2 * e) * SS] = (u16)(raw[q][e] & 0xffff);
            dst[(size_t)(2 * e + 1) * SS] = (u16)(raw[q][e] >> 16);
          }
        }
      }
    } else if (part == 2) {
      __syncthreads();
#pragma unroll
      for (int hb = 0; hb < 2; hb++) {
        u32x4 ru[4], rv2[4];
#pragma unroll
        for (int q = 0; q < 4; q++) {
          const int idx = (hb * 4 + q) * 256 + tid;
          const int t = idx >> 5, c = idx & 31;
          ru[q] = *(const u32x4*)(Z + (size_t)(m0 + t) * ZW + 1248 + c * 8);
          rv2[q] = *(const u32x4*)(Z + (size_t)(m0 + t) * ZW + 1504 + c * 8);
        }
#pragma unroll
        for (int q = 0; q < 4; q++) {
          const int idx = (hb * 4 + q) * 256 + tid;
          const int t = idx >> 5, c = idx & 31;
          float v[8];
          unpack8(ru[q], v);
#pragma unroll
          for (int e = 0; e < 8; e++) v[e] = gelu_f(v[e]);
          store8(QKV + SG_U + (size_t)(m0 + t) * 256 + c * 8, v);
          unpack8(rv2[q], v);
          float ss = 0.f;
#pragma unroll
          for (int e = 0; e < 8; e++) { float g = gelu_f(v[e]); ss += g * g; }
#pragma unroll
          for (int o = 1; o <= 16; o <<= 1) ss += shfl_xor_f(ss, o);
          if (c == 0) rstd_l[t] = rsqrtf(ss * (1.f / 256.f) + EPS);
        }
      }
      __syncthreads();
      {
        u32x4 raw[8];
#pragma unroll
        for (int q = 0; q < 8; q++) raw[q] = *(const u32x4*)(Z + (size_t)(m0 + lane) * ZW + 1504 + (w + 4 * q) * 8);
        const float rs = rstd_l[lane];
        const int mm = m0 + lane;
#pragma unroll
        for (int q = 0; q < 8; q++) {
          const int ct = w + 4 * q;
          float v[8];
          unpack8(raw[q], v);
          u16* dst = QKV + SG_VT + (size_t)(mm >> 7) * 32768 + (size_t)(ct * 8) * 128 + (mm & 127);
#pragma unroll
          for (int e = 0; e < 8; e++) dst[e * 128] = f2bf(gelu_f(v[e]) * rs * sgv_n[ct * 8 + e]);
        }
      }
    }
  }
}

#define XB_TMO      128
#define XB_XCNT(j)  (256  + 64 * (j))
#define XB_XSUB(j)  (1280 + 64 * (j))
#define XB_XGEN(j)  (2304 + 64 * (j))
#define XB_TOP      3328
#define XB_TOPGEN   3392
#define XCD_BAR_WORDS 3456
#define XB_SPIN_CAP (1u << 18)
#define LAS __attribute__((address_space(3)))

__device__ __forceinline__ unsigned xb_ld(unsigned* p)              { return __hip_atomic_load(p, __ATOMIC_RELAXED, __HIP_MEMORY_SCOPE_AGENT); }
__device__ __forceinline__ unsigned xb_add(unsigned* p, unsigned v) { return __hip_atomic_fetch_add(p, v, __ATOMIC_RELAXED, __HIP_MEMORY_SCOPE_AGENT); }
__device__ __forceinline__ unsigned xb_xcc_id() { return (unsigned)__builtin_amdgcn_s_getreg((3 << 11) | 20) & 0xFu; }
#define XB_SPIN(cond, bar) do { unsigned _sp = 0; while (cond) { __builtin_amdgcn_s_sleep(1); \
    if ((++_sp & 255u) == 0u) { if (xb_ld(&(bar)[XB_TMO])) break; if (_sp > XB_SPIN_CAP) { atomicAdd(&(bar)[XB_TMO], 1u); break; } } } } while (0)

struct XcdBarrier {
    unsigned* bar; unsigned x;
    volatile LAS unsigned* st;
};

__device__ __forceinline__ XcdBarrier xcd_barrier_post(unsigned* bar, volatile LAS unsigned* st) {
    XcdBarrier b; b.bar = bar; b.x = (unsigned)__builtin_amdgcn_readfirstlane((int)xb_xcc_id()); b.st = st;
    if (threadIdx.x == 0) (void)xb_add(&bar[XB_XCNT(b.x)], 1u);
    return b;
}
__device__ __forceinline__ void xcd_barrier_complete(unsigned* bar, unsigned x, unsigned& nloc, unsigned& nx) {
    const unsigned G = gridDim.x * gridDim.y * gridDim.z;
    unsigned sum, cnt, mine, sp = 0u;
    for (;;) {
        sum = 0u; cnt = 0u; mine = 0u;
#pragma unroll
        for (unsigned j = 0; j < 16; ++j) { const unsigned c = xb_ld(&bar[XB_XCNT(j)]); sum += c; cnt += (c > 0u) ? 1u : 0u; mine = (j == x) ? c : mine; }
        if (sum == G) break;
        __builtin_amdgcn_s_sleep(1);
        if ((++sp & 255u) == 0u) { if (xb_ld(&bar[XB_TMO])) break; if (sp > XB_SPIN_CAP) { atomicAdd(&bar[XB_TMO], 1u); break; } }
    }
    nloc = mine > 0u ? mine : 1u; nx = cnt > 0u ? cnt : 1u;
}

__device__ __forceinline__ void xcd_barrier(const XcdBarrier& b) {
    asm volatile("s_waitcnt vmcnt(0)" ::: "memory");
    __syncthreads();
    if (threadIdx.x == 0) {
        unsigned* bar = b.bar;
        __builtin_amdgcn_s_waitcnt(0);
        unsigned nloc = b.st[0], nx = b.st[1];
        if (nloc == 0u) { xcd_barrier_complete(bar, b.x, nloc, nx); b.st[0] = nloc; b.st[1] = nx; }
        const unsigned old = xb_add(&bar[XB_XSUB(b.x)], 1u);
        const unsigned gen = old / nloc;
        if (old + 1u == (gen + 1u) * nloc) {
            __builtin_amdgcn_fence(__ATOMIC_RELEASE, "agent");
            asm volatile("s_waitcnt vmcnt(0)" ::: "memory");
            const unsigned og = xb_add(&bar[XB_TOP], 1u);
            const unsigned tg = og / nx;
            if (og + 1u == (tg + 1u) * nx) xb_add(&bar[XB_TOPGEN], 1u);
            else XB_SPIN(xb_ld(&bar[XB_TOPGEN]) == tg, bar);
            __builtin_amdgcn_fence(__ATOMIC_ACQUIRE, "agent");
            xb_add(&bar[XB_XGEN(b.x)], 1u);
            asm volatile("s_waitcnt vmcnt(0)" ::: "memory");
        } else {
            XB_SPIN(xb_ld(&bar[XB_XGEN(b.x)]) == gen, bar);
            __builtin_amdgcn_fence(__ATOMIC_ACQUIRE, "agent");
            asm volatile("s_waitcnt vmcnt(0)" ::: "memory");
        }
    }
    __syncthreads();
}


__global__ void __launch_bounds__(256, 2) fwd_megakernel(Params p) {
  __shared__ __attribute__((aligned(16))) char smem[SMEM_BYTES];
  cg::grid_group grid = cg::this_grid();
  __shared__ __attribute__((aligned(16))) unsigned xb_st[4];
  if (threadIdx.x < 4) xb_st[threadIdx.x] = 0u;
  __syncthreads();
  XcdBarrier xbar = xcd_barrier_post((unsigned*)(p.ws + WS_BAR), (volatile LAS unsigned*)xb_st);
  const int G = gridDim.x;
  const int vb = ((G & 7) == 0) ? ((blockIdx.x & 7) * (G >> 3) + (blockIdx.x >> 3)) : (int)blockIdx.x;
  const int tid = opaque_tid(), lane = tid & 63, w = tid >> 6, l15 = lane & 15, quad = lane >> 4;
  const int wm = w >> 1, wn = w & 1;
  u16* ldsu = (u16*)smem;
  float* ldsf = (float*)smem;

  u16* H = (u16*)(p.ws + WS_H);
  u16* Z = (u16*)(p.ws + WS_Z);
  u16* O = Z;
  u16* Y = Z + (size_t)MM * 1024;
  u16* QKV = (u16*)(p.ws + WS_QKV);
  u16* ACT = QKV;
  const float2* R8 = (const float2*)(p.ws + WS_R8);

  for (int rep_ = 0; rep_ < REP_SYNC; rep_++) grid.sync();
#ifndef SKIP_P0
  for (int rep_ = 0; rep_ < REP_P0; rep_++) phase0(p, vb, G, smem);
#endif
  if (gridDim.y > 1) grid.sync();

  for (int l = 0; l < 2; l++) {
    xcd_barrier(xbar);
    const u16* W = (const u16*)(p.ws + WS_W) + (size_t)l * WL;
    const float* modl = (const float*)(p.ws + WS_MOD) + (size_t)l * 5 * 6144;
    XMap xin, xout;
    if (l == 0) { xin.lat = (float*)p.in[0]; xin.ctx = (float*)p.in[2]; }
    else { xin.lat = p.out; xin.ctx = (float*)(p.ws + WS_CX); }
    xout.lat = p.out; xout.ctx = (float*)(p.ws + WS_CX);
    const bool last = (l == 1);

#ifndef SKIP_P1
    for (int rep_ = 0; rep_ < REP_P1; rep_++) {
    phase_modulate(xin, modl, 0, 1, H, false, vb, G);
    }
#endif
    xcd_barrier(xbar);

#ifndef SKIP_P2
    {
    for (int rep_ = 0; rep_ < REP_P2; rep_++) {
    const int tid = opaque_tid(), lane = tid & 63, w = tid >> 6, l15 = lane & 15, quad = lane >> 4;
    const int wm = w >> 1, wn = w & 1;
    (void)wm; (void)wn; (void)l15; (void)quad;
    for (int it = vb; it < 264 * 9; it += G) {
      const int g8 = it / (8 * 9);
      const int rem = it - g8 * (8 * 9);
      const int nt = rem >> 3;
      const int mt = g8 * 8 + (rem & 7);
      const int m0 = mt * 128, n0 = nt * 256;
      f32x4 acc[4][8];
      gemm_wide([&](int r) { return (const u16*)(H + (size_t)(m0 + r) * DD); },
                [&](int n) { return (const u16*)(W + OW_IN + (size_t)(n0 + n) * 1024); }, 32, acc, ldsu);
      const int tid = opaque_tid(), lane = tid & 63, w = tid >> 6, l15 = lane & 15, quad = lane >> 4, wm = w >> 1, wn = w & 1; (void)lane; (void)wm; (void)wn; (void)l15; (void)quad;
      u16* zb = Z + (size_t)m0 * ZW + n0;
#pragma unroll
      for (int i = 0; i < 4; i++)
#pragma unroll
        for (int j = 0; j < 8; j++)
#pragma unroll
          for (int e = 0; e < 4; e++) zb[ACC_ROW(i, e) * ZW + ACC_COLW(j)] = f2bf(acc[i][j][e]);
    }
    }
    }
#endif
    xcd_barrier(xbar);

#ifndef SKIP_P4
    {
    for (int rep_ = 0; rep_ < REP_P4; rep_++) {
    const int tid = opaque_tid(), lane = tid & 63, w = tid >> 6, l15 = lane & 15, quad = lane >> 4;
    const int wm = w >> 1, wn = w & 1;
    (void)wm; (void)wn; (void)l15; (void)quad;
    {
      const float* mla_qn = p.in[14] + l * 96;
      const float* mla_kn = p.in[15] + l * 96;
      for (int it = vb; it < 264 * 8 + (MM / 64) * 3; it += G) {
        if (it >= 264 * 8) { prep_item(p, l, it - 264 * 8, smem); continue; }
        const int mt = it >> 3, hh = it & 7;
        const int m0 = mt * 128;
        const int b = m0 / SS, s0 = m0 - b * SS;
        if (hh < 4) {
          const int h = hh;
          f32x4 acc[4][3];
          gemm_core<96>([&](int r) { return (const u16*)(Z + (size_t)(m0 + r) * ZW + 768); },
                        [&](int n) { return (const u16*)(W + OW_UQ + (size_t)(h * 96 + n) * 256); }, 4, acc, ldsu);
      const int tid = opaque_tid(), lane = tid & 63, w = tid >> 6, l15 = lane & 15, quad = lane >> 4, wm = w >> 1, wn = w & 1; (void)lane; (void)wm; (void)wn; (void)l15; (void)quad;
          acc_to_lds<96>(acc, ldsf);
          __syncthreads();
          const int t = tid >> 1, hs = tid & 1;
          const int s = s0 + t;
          u16* dst = QKV + Q_MLA + ((size_t)(b * 4 + h) * SS + s) * 96;
          const float* st = ldsf + t * 97;
          float rq;
          {
            const u16* zr = Z + (size_t)(m0 + t) * ZW + 768 + hs * 128;
            u32x4 raw[16];
#pragma unroll
            for (int c = 0; c < 16; c++) raw[c] = *(const u32x4*)(zr + c * 8);
            float sq = 0.f;
#pragma unroll
            for (int c = 0; c < 16; c++) {
              float v[8];
              unpack8(raw[c], v);
#pragma unroll
              for (int e = 0; e < 8; e++) sq += v[e] * v[e];
            }
            sq += shfl_xor_f(sq, 1);
            rq = rsqrtf(sq * (1.f / 256.f) + EPS);
          }
          if (hs == 0) {
            float ss = 0.f;
#pragma unroll
            for (int e = 0; e < 64; e++) ss += st[e] * st[e];
            ss *= rq * rq;
            const float rstd = rq * rsqrtf(ss * (1.f / 64.f) + EPS);
#pragma unroll
            for (int c = 0; c < 8; c++) {
              float v[8];
#pragma unroll
              for (int e = 0; e < 8; e++) v[e] = st[c * 8 + e] * rstd * mla_qn[c * 8 + e];
              store8(dst + c * 8, v);
            }
          } else {
            float ss = 0.f;
#pragma unroll
            for (int e = 0; e < 32; e++) ss += st[64 + e] * st[64 + e];
            ss *= rq * rq;
            const float rstd = rq * rsqrtf(ss * (1.f / 32.f) + EPS);
            float x1[8], x2[8], y1[8], y2[8];
#pragma unroll
            for (int e = 0; e < 8; e++) {
              x1[e] = st[64 + e] * rstd * mla_qn[64 + e];
              x2[e] = st[72 + e] * rstd * mla_qn[72 + e];
              y1[e] = st[80 + e] * rstd * mla_qn[80 + e];
              y2[e] = st[88 + e] * rstd * mla_qn[88 + e];
            }
            if (s >= CC) {
              const int tl = s - CC;
              const int prow = tl >> 6, pcol = tl & 63;
#pragma unroll
              for (int e = 0; e < 8; e++) {
                float2 cr = R8[prow * 8 + e];
                float2 cc = R8[pcol * 8 + e];
                float a1 = x1[e] * cr.x - x2[e] * cr.y;
                float a2 = x2[e] * cr.x + x1[e] * cr.y;
                float b1 = y1[e] * cc.x - y2[e] * cc.y;
                float b2 = y2[e] * cc.x + y1[e] * cc.y;
                x1[e] = a1; x2[e] = a2; y1[e] = b1; y2[e] = b2;
              }
            }
            store8(dst + 64, x1); store8(dst + 72, x2); store8(dst + 80, y1); store8(dst + 88, y2);
          }
        } else {
          const int h = hh - 4;
          f32x4 acc[4][4];
          gemm_core<128>([&](int r) { return (const u16*)(Z + (size_t)(m0 + r) * ZW + 1024); },
                         [&](int n) { return (const u16*)(W + OW_UKV + (size_t)(h * 128 + n) * 192); }, 3, acc, ldsu);
      const int tid = opaque_tid(), lane = tid & 63, w = tid >> 6, l15 = lane & 15, quad = lane >> 4, wm = w >> 1, wn = w & 1; (void)lane; (void)wm; (void)wn; (void)l15; (void)quad;
          acc_to_lds<128>(acc, ldsf);
          __syncthreads();
          float* rs_l = ldsf + 128 * 129;
          {
            const int t = tid >> 1, hs = tid & 1;
            const int s = s0 + t;
            float rkv;
            {
              const u16* zr = Z + (size_t)(m0 + t) * ZW + 1024 + hs * 96;
              u32x4 raw[12];
#pragma unroll
              for (int c = 0; c < 12; c++) raw[c] = *(const u32x4*)(zr + c * 8);
              float sq = 0.f;
#pragma unroll
              for (int c = 0; c < 12; c++) {
                float v[8];
                unpack8(raw[c], v);
#pragma unroll
                for (int e = 0; e < 8; e++) sq += v[e] * v[e];
              }
              sq += shfl_xor_f(sq, 1);
              rkv = rsqrtf(sq * (1.f / 192.f) + EPS);
            }
            if (hs == 1) {
              float x1[8], x2[8], y1[8], y2[8];
              const u16* zk = Z + (size_t)(m0 + t) * ZW + 1216;
              load8(zk, x1); load8(zk + 8, x2); load8(zk + 16, y1); load8(zk + 24, y2);
              float ssr = 0.f;
#pragma unroll
              for (int e = 0; e < 8; e++) ssr += x1[e] * x1[e] + x2[e] * x2[e] + y1[e] * y1[e] + y2[e] * y2[e];
              const float rr = rsqrtf(ssr * (1.f / 32.f) + EPS);
#pragma unroll
              for (int e = 0; e < 8; e++) {
                x1[e] *= rr * mla_kn[64 + e]; x2[e] *= rr * mla_kn[72 + e];
                y1[e] *= rr * mla_kn[80 + e]; y2[e] *= rr * mla_kn[88 + e];
              }
              if (s >= CC) {
                const int tl = s - CC;
                const int prow = tl >> 6, pcol = tl & 63;
#pragma unroll
                for (int e = 0; e < 8; e++) {
                  const float2 cr = R8[prow * 8 + e];
                  const float2 cc2 = R8[pcol * 8 + e];
                  const float a1 = x1[e] * cr.x - x2[e] * cr.y;
                  const float a2 = x2[e] * cr.x + x1[e] * cr.y;
                  const float b1 = y1[e] * cc2.x - y2[e] * cc2.y;
                  const float b2 = y2[e] * cc2.x + y1[e] * cc2.y;
                  x1[e] = a1; x2[e] = a2; y1[e] = b1; y2[e] = b2;
                }
              }
              u16* dstr = QKV + K_MLA + ((size_t)(b * 4 + h) * SS + s) * 96 + 64;
              store8(dstr, x1); store8(dstr + 8, x2); store8(dstr + 16, y1); store8(dstr + 24, y2);
            }
            if (hs == 0) {
              rs_l[t] = rkv;
              const float* st = ldsf + t * 129;
              float ss = 0.f;
#pragma unroll
              for (int e = 0; e < 64; e++) ss += st[e] * st[e];
              ss *= rkv * rkv;
              const float rstd = rkv * rsqrtf(ss * (1.f / 64.f) + EPS);
              u16* dst = QKV + K_MLA + ((size_t)(b * 4 + h) * SS + s) * 96;
#pragma unroll
              for (int c = 0; c < 8; c++) {
                float v[8];
#pragma unroll
                for (int e = 0; e < 8; e++) v[e] = st[c * 8 + e] * rstd * mla_kn[c * 8 + e];
                store8(dst + c * 8, v);
              }
            }
          }
          __syncthreads();
          {
            const int t = tid & 127, half = tid >> 7;
            const int sp = perm32(s0 + t);
            u16* dst = QKV + V_MLA + ((size_t)(b * 4 + h) * 64 + half * 32) * SS + sp;
            const float* st = ldsf + t * 129 + 64 + half * 32;
            const float rkv = rs_l[t];
#pragma unroll 8
            for (int e = 0; e < 32; e++) dst[(size_t)e * SS] = f2bf(st[e] * rkv);
          }
        }
      }
    }
    }
    }
#endif
    xcd_barrier(xbar);

#ifndef SKIP_P6
    {
    for (int rep_ = 0; rep_ < REP_P6; rep_++) {
    const int tid = opaque_tid(), lane = tid & 63, w = tid >> 6, l15 = lane & 15, quad = lane >> 4;
    const int wm = w >> 1, wn = w & 1;
    (void)wm; (void)wn; (void)l15; (void)quad;
    {
      const float sc_mla = 0.10206207261596575f * LOG2E;
      const float sc_64 = 0.125f * LOG2E;
      float* rpb_lds = (float*)(smem + 49152);
      const float* rpb = p.in[9] + (size_t)l * 4 * 465;
      const float* sgb = p.in[18] + (size_t)l * 512;
      const int nctx = last ? 0 : 96;
      float mref_mla, mref_gqa, mref_na;
      {
        float* red = (float*)(smem + 60000);
        __syncthreads();
        if (w == 0) {
          auto amax = [&](const float* v, int lo, int hi) {
            float m = 0.f;
            for (int i = lo + lane; i < hi; i += 64) m = fmaxf(m, fabsf(v[i]));
#pragma unroll
            for (int o = 32; o >= 1; o >>= 1) m = fmaxf(m, shfl_xor_f(m, o));
            return m;
          };
          const float naq = amax(p.in[7] + l * 64, 0, 64), nak = amax(p.in[8] + l * 64, 0, 64);
          const float gqq = amax(p.in[19] + l * 64, 0, 64), gqk = amax(p.in[20] + l * 64, 0, 64);
          const float mq1 = amax(p.in[14] + l * 96, 0, 64), mq2 = amax(p.in[14] + l * 96, 64, 96);
          const float mk1 = amax(p.in[15] + l * 96, 0, 64), mk2 = amax(p.in[15] + l * 96, 64, 96);
          const float rb = amax(rpb, 0, 4 * 465);
          if (lane == 0) {
            red[0] = sqrtf(64.f * mq1 * mq1 + 32.f * mq2 * mq2) * sqrtf(64.f * mk1 * mk1 + 32.f * mk2 * mk2) * 0.10206207261596575f * LOG2E;
            red[1] = 8.f * gqq * 8.f * gqk * 0.125f * LOG2E;
            red[2] = (8.f * naq * 8.f * nak * 0.125f + rb) * LOG2E;
          }
        }
        __syncthreads();
        mref_mla = red[0]; mref_gqa = red[1]; mref_na = red[2];
      }
      const int total = 1024 + 1024 + 1024 + 1056 + nctx;
      for (int it = vb; it < total; it += G) {
        int kind;
        const u16* Qp = nullptr; const u16* Kp = nullptr; const u16* Vp = nullptr; u16* Op = nullptr;
        int q0 = 0, t0 = 0, n0 = 0, t1 = 0, n1 = 0, r0 = 0, hsel = 0;
        int sg_ec = 0, sg_g = 0;
        float mref1 = mref_gqa;
        if (it < 3072) {
          const int typ = it >> 10;
          const int j = it & 1023;
          const int qt = j & 63, h = (j >> 6) & 3, b = j >> 8;
          q0 = CC + qt * 128;
          hsel = h;
          if (typ == 0) {
            kind = 0;
            Qp = QKV + Q_MLA + (size_t)(b * 4 + h) * SS * 96; Kp = QKV + K_MLA + (size_t)(b * 4 + h) * SS * 96;
            Vp = QKV + V_MLA + (size_t)(b * 4 + h) * 64 * SS; Op = O + (size_t)(b * SS + q0) * 1024 + 256 + h * 64;
            t0 = 0; n0 = 132;
          } else if (typ == 1) {
            kind = 1;
            const int g = h >> 1;
            Qp = QKV + Q_GQA + (size_t)(b * 4 + h) * SS * 64; Kp = QKV + K_GQA + (size_t)(b * 2 + g) * SS * 64;
            Vp = QKV + V_GQA + (size_t)(b * 2 + g) * 64 * SS; Op = O + (size_t)(b * SS + q0) * 1024 + 768 + h * 64;
            t0 = 0; n0 = 132;
          } else {
            kind = 2;
            r0 = qt * 2;
            const int bs = clampi(r0 - 4, 0, 120);
            const int be = clampi(r0 + 1 - 4, 0, 120) + 8;
            Qp = QKV + Q_NA + (size_t)(b * 4 + h) * SS * 64; Kp = QKV + K_NA + (size_t)(b * 4 + h) * SS * 64;
            Vp = QKV + V_NA + (size_t)(b * 4 + h) * 64 * SS; Op = O + (size_t)(b * SS + q0) * 1024 + 0 + h * 64;
            t0 = 0; n0 = 4; t1 = 4 + bs; n1 = be - bs;
          }
        } else if (it < 3072 + 1056) {
          kind = 3;
          const int j = it - 3072;
          sg_ec = j >> 2; sg_g = j & 3;
        } else {
          const int j = it - (3072 + 1056);
          const int typ = j >> 5, rem = j & 31;
          const int qt = rem & 1, h = (rem >> 1) & 3, b = rem >> 3;
          q0 = qt * 128;
          t0 = 0; n0 = 4;
          if (typ == 1) {
            kind = 0;
            Qp = QKV + Q_MLA + (size_t)(b * 4 + h) * SS * 96; Kp = QKV + K_MLA + (size_t)(b * 4 + h) * SS * 96;
            Vp = QKV + V_MLA + (size_t)(b * 4 + h) * 64 * SS; Op = O + (size_t)(b * SS + q0) * 1024 + 256 + h * 64;
          } else if (typ == 0) {
            kind = 1;
            mref1 = mref_na;
            Qp = QKV + Q_NA + (size_t)(b * 4 + h) * SS * 64; Kp = QKV + K_NA + (size_t)(b * 4 + h) * SS * 64;
            Vp = QKV + V_NA + (size_t)(b * 4 + h) * 64 * SS; Op = O + (size_t)(b * SS + q0) * 1024 + 0 + h * 64;
          } else {
            kind = 1;
            const int g = h >> 1;
            Qp = QKV + Q_GQA + (size_t)(b * 4 + h) * SS * 64; Kp = QKV + K_GQA + (size_t)(b * 2 + g) * SS * 64;
            Vp = QKV + V_GQA + (size_t)(b * 2 + g) * 64 * SS; Op = O + (size_t)(b * SS + q0) * 1024 + 768 + h * 64;
          }
        }
        if (kind == 0) {
#ifndef NO_A96
          attn_item<96, false>(Qp, Kp, Vp, q0, t0, n0, t1, n1, sc_mla, mref_mla, Op, 0, nullptr, ldsu, rpb_lds);
#endif
        } else if (kind == 1) {
#ifndef NO_A64
          attn_item<64, false>(Qp, Kp, Vp, q0, t0, n0, t1, n1, sc_64, mref1, Op, 0, nullptr, ldsu, rpb_lds);
#endif
        } else if (kind == 2) {
#ifndef NO_NA
          attn_item<64, true>(Qp, Kp, Vp, q0, t0, n0, t1, n1, sc_64, mref_na, Op, r0, rpb + hsel * 465, ldsu, rpb_lds);
#endif
        } else {
          const int ec = sg_ec, g = sg_g;
          f32x4 acc[4][2];
          gemm_core<64>([&](int r) { return (const u16*)(W + OW_SG + (size_t)(g * 128 + r) * 128); },
                        [&](int n) { return (const u16*)(QKV + SG_VT + (size_t)ec * 32768 + (size_t)(g * 64 + n) * 128); }, 2, acc, ldsu);
      const int tid = opaque_tid(), lane = tid & 63, w = tid >> 6, l15 = lane & 15, quad = lane >> 4, wm = w >> 1, wn = w & 1; (void)lane; (void)wm; (void)wn; (void)l15; (void)quad;
          asm volatile("" ::: "memory");
          const u16* ub = QKV + SG_U + (size_t)ec * 128 * 256 + g * 64;
          u16* ob = O + (size_t)ec * 128 * 1024 + 512 + g * 64;
          const float* sb = sgb + g * 128;
          float uu[4][2][4];
#pragma unroll
          for (int i = 0; i < 4; i++)
#pragma unroll
            for (int jj = 0; jj < 2; jj++)
#pragma unroll
              for (int e = 0; e < 4; e++) uu[i][jj][e] = bf2f(ub[ACC_ROW(i, e) * 256 + ACC_COL(64, jj)]);
#pragma unroll
          for (int i = 0; i < 4; i++)
#pragma unroll
            for (int e = 0; e < 4; e++) {
              const int pr = ACC_ROW(i, e);
              const float bb = sb[pr];
#pragma unroll
              for (int jj = 0; jj < 2; jj++) ob[pr * 1024 + ACC_COL(64, jj)] = f2bf(uu[i][jj][e] * (acc[i][jj][e] + bb));
            }
        }
      }
    }

    }
    }
#endif
    xcd_barrier(xbar);

#ifndef SKIP_P7
    {
    for (int rep_ = 0; rep_ < REP_P7; rep_++) {
    const int tid = opaque_tid(), lane = tid & 63, w = tid >> 6, l15 = lane & 15, quad = lane >> 4;
    const int wm = w >> 1, wn = w & 1;
    (void)wm; (void)wn; (void)l15; (void)quad;
    {
      const float* bg = p.in[23] + (size_t)l * 4096;
      for (int it = vb; it < (last ? 256 : 264) * 16; it += G) {
        const int mi = it >> 4, nt = it & 15;
        const int mt = last ? ((mi >> 6) * 66 + 2 + (mi & 63)) : mi;
        const int m0 = mt * 128, n0 = nt * 64;
        f32x4 y[4][2];
#pragma unroll
        for (int i = 0; i < 4; i++)
#pragma unroll
          for (int j = 0; j < 2; j++) y[i][j] = f32x4{0.f, 0.f, 0.f, 0.f};
        for (int br = 0; br < 4; br++) {
          f32x4 ag[4][2], ap2[4][2];
          gemm_dual<64>([&](int r) { return (const u16*)(H + (size_t)(m0 + r) * DD); },
                        [&](int n) { return (const u16*)(W + OW_GATE + (size_t)br * 1048576 + (size_t)(n0 + n) * 1024); }, 16, ag,
                        [&](int r) { return (const u16*)(O + (size_t)(m0 + r) * 1024 + br * 256); },
                        [&](int n) { return (const u16*)(W + OW_BRANCH + (size_t)br * 262144 + (size_t)(n0 + n) * 256); }, 4, ap2, ldsu);
      const int tid = opaque_tid(), lane = tid & 63, w = tid >> 6, l15 = lane & 15, quad = lane >> 4, wm = w >> 1, wn = w & 1; (void)lane; (void)wm; (void)wn; (void)l15; (void)quad;
#pragma unroll
          for (int j = 0; j < 2; j++) {
            const float bv = bg[br * 1024 + n0 + ACC_COL(64, j)];
#pragma unroll
            for (int i = 0; i < 4; i++)
#pragma unroll
              for (int e = 0; e < 4; e++) y[i][j][e] += sigmoid_f(ag[i][j][e] + bv) * ap2[i][j][e];
          }
        }
#pragma unroll
        for (int i = 0; i < 4; i++)
#pragma unroll
          for (int j = 0; j < 2; j++)
#pragma unroll
            for (int e = 0; e < 4; e++) Y[(size_t)(m0 + ACC_ROW(i, e)) * 1024 + n0 + ACC_COL(64, j)] = f2bf(y[i][j][e]);
      }
    }
    }
    }
#endif
    xcd_barrier(xbar);

#ifndef SKIP_P8
    {
    {
    const int tid = opaque_tid(), lane = tid & 63, w = tid >> 6, l15 = lane & 15, quad = lane >> 4;
    const int wm = w >> 1, wn = w & 1;
    (void)wm; (void)wn; (void)l15; (void)quad;
    {
    const int nwide = 256 * 4;
    const int total_items = nwide + (last ? 0 : 64);
    for (int it = vb; it < total_items; it += G) {
      if (it < nwide) {
        const int mi = it >> 2, nt = it & 3;
        const int mt = (mi >> 6) * 66 + 2 + (mi & 63);
        const int m0 = mt * 128, n0 = nt * 256;
        const int b = m0 / SS;
        f32x4 acc[4][8];
        gemm_wide([&](int r) { return (const u16*)(Y + (size_t)(m0 + r) * 1024); },
                  [&](int n) { return (const u16*)(W + OW_OUT + (size_t)(n0 + n) * 1024); }, 32, acc, ldsu);
        const int tid = opaque_tid(), lane = tid & 63, w = tid >> 6, l15 = lane & 15, quad = lane >> 4, wm = w >> 1, wn = w & 1; (void)lane; (void)wm; (void)wn; (void)l15; (void)quad;
        const float* g1 = modl + (size_t)b * 6144 + 2 * 1024;
        const float* xi = xrow(xin, m0) + n0;
        float* xo = xrow(xout, m0) + n0;
        asm volatile("" ::: "memory");
#pragma unroll
        for (int jh = 0; jh < 4; jh++) {
          float xv[2][4][4];
#pragma unroll
          for (int j = 0; j < 2; j++)
#pragma unroll
            for (int i = 0; i < 4; i++)
#pragma unroll
              for (int e = 0; e < 4; e++) xv[j][i][e] = xi[ACC_ROW(i, e) * 1024 + ACC_COLW(jh * 2 + j)];
#pragma unroll
          for (int j = 0; j < 2; j++) {
            const float gv = g1[n0 + ACC_COLW(jh * 2 + j)];
#pragma unroll
            for (int i = 0; i < 4; i++)
#pragma unroll
              for (int e = 0; e < 4; e++) xo[ACC_ROW(i, e) * 1024 + ACC_COLW(jh * 2 + j)] = xv[j][i][e] + gv * acc[i][jh * 2 + j][e];
          }
        }
        continue;
      }
      const int jc = it - nwide;
      const int mc = jc >> 3, nt = jc & 7;
      const int mt = (mc >> 1) * 66 + (mc & 1);
      const int m0 = mt * 128, n0 = nt * 128;
      const int b = m0 / SS, s0 = m0 - b * SS;
      const int mrow = (s0 < CC) ? 4 : b;
      f32x4 acc[4][4];
      gemm_core<128>([&](int r) { return (const u16*)(Y + (size_t)(m0 + r) * 1024); },
                     [&](int n) { return (const u16*)(W + OW_OUT + (size_t)(n0 + n) * 1024); }, 16, acc, ldsu);
      const int tid = opaque_tid(), lane = tid & 63, w = tid >> 6, l15 = lane & 15, quad = lane >> 4, wm = w >> 1, wn = w & 1; (void)lane; (void)wm; (void)wn; (void)l15; (void)quad;
      const float* g1 = modl + (size_t)mrow * 6144 + 2 * 1024;
      const float* xi = xrow(xin, m0) + n0;
      float* xo = xrow(xout, m0) + n0;
      asm volatile("" ::: "memory");
#pragma unroll
      for (int jh = 0; jh < 2; jh++) {
        float xv[2][4][4];
#pragma unroll
        for (int j = 0; j < 2; j++)
#pragma unroll
          for (int i = 0; i < 4; i++)
#pragma unroll
            for (int e = 0; e < 4; e++) xv[j][i][e] = xi[ACC_ROW(i, e) * 1024 + ACC_COL(128, jh * 2 + j)];
#pragma unroll
        for (int j = 0; j < 2; j++) {
          const float gv = g1[n0 + ACC_COL(128, jh * 2 + j)];
#pragma unroll
          for (int i = 0; i < 4; i++)
#pragma unroll
            for (int e = 0; e < 4; e++) xo[ACC_ROW(i, e) * 1024 + ACC_COL(128, jh * 2 + j)] = xv[j][i][e] + gv * acc[i][jh * 2 + j][e];
        }
      }
    }
    }
    }
    }
#endif
    xcd_barrier(xbar);

#ifndef SKIP_P9
    for (int rep_ = 0; rep_ < REP_P9; rep_++) {
    phase_modulate(xout, modl, 3, 4, H, last, vb, G);
    }
#endif
    xcd_barrier(xbar);

#ifndef SKIP_P10
    {
    for (int rep_ = 0; rep_ < REP_P10; rep_++) {
    const int tid = opaque_tid(), lane = tid & 63, w = tid >> 6, l15 = lane & 15, quad = lane >> 4;
    const int wm = w >> 1, wn = w & 1;
    (void)wm; (void)wn; (void)l15; (void)quad;
    {
      const float* cw = p.in[26] + (size_t)l * 3 * 5632;
      const float* cb = p.in[27] + (size_t)l * 5632;
      const int tpb = last ? 66 : 69;
      const int total = NB * tpb * 22;
      for (int it = vb; it < total; it += G) {
        const int MT = NB * tpb;
        const int g8 = it / (8 * 22);
        const int rem = it - g8 * (8 * 22);
        const int gsz = (MT - g8 * 8) < 8 ? (MT - g8 * 8) : 8;
        const int nt = rem / gsz;
        const int mt = g8 * 8 + (rem - nt * gsz);
        const int b = mt / tpb;
        int ti = mt - b * tpb;
        int seg_lo, seg_hi;
        if (last) { seg_lo = CC; seg_hi = SS; }
        else if (ti < 3) { seg_lo = 0; seg_hi = CC; }
        else { ti -= 3; seg_lo = CC; seg_hi = SS; }
        const int sfirst = seg_lo + 126 * ti - 1;
        const int c0 = nt * 128;
        f32x4 acc[4][8];
        gemm_wide([&](int r) { int s = sfirst + r; return (s >= seg_lo && s < seg_hi) ? (const u16*)(H + (size_t)(b * SS + s) * DD) : (const u16*)(p.ws + WS_ZROW); },
                  [&](int n) { int ch = ((n >> 7) ? FF : 0) + c0 + (n & 127); return (const u16*)(W + OW_UP + (size_t)ch * 1024); }, 32, acc, ldsu);
      const int tid = opaque_tid(), lane = tid & 63, w = tid >> 6, l15 = lane & 15, quad = lane >> 4, wm = w >> 1, wn = w & 1; (void)lane; (void)wm; (void)wn; (void)l15; (void)quad;
#pragma unroll
        for (int pss = 0; pss < 2; pss++) {
        if (pss) __syncthreads();
#pragma unroll
        for (int i = 0; i < 4; i++)
#pragma unroll
          for (int j = 0; j < 4; j++)
            *(f32x4*)(ldsf + ACC_COL(128, j) * 132 + wm * 64 + i * 16 + quad * 4) = acc[i][pss * 4 + j];
        __syncthreads();
        const int cc = tid & 63, rg = tid >> 6;
        const int ch = c0 + pss * 64 + cc;
        const float wa0 = cw[ch], wa1 = cw[5632 + ch], wa2 = cw[2 * 5632 + ch], ba = cb[ch];
        const float wg0 = cw[FF + ch], wg1 = cw[5632 + FF + ch], wg2 = cw[2 * 5632 + FF + ch], bgv = cb[FF + ch];
        u16* actb = ACT + (size_t)(b * SS) * FF + ch;
        const float* sa = ldsf + cc * 132;
        const float* sg = ldsf + (64 + cc) * 132;
#pragma unroll 4
        for (int i = 0; i < 8; i++) {
          const int r0 = (rg + 4 * i) * 4;
          const f32x4 a4 = *(const f32x4*)(sa + r0);
          const f32x4 g4 = *(const f32x4*)(sg + r0);
          const float am = (r0 > 0) ? sa[r0 - 1] : 0.f, ap = sa[r0 + 4];
          const float gm = (r0 > 0) ? sg[r0 - 1] : 0.f, gp = sg[r0 + 4];
          float av[4], gv[4];
          av[0] = wa0 * am + wa1 * a4[0] + wa2 * a4[1] + ba;
          av[1] = wa0 * a4[0] + wa1 * a4[1] + wa2 * a4[2] + ba;
          av[2] = wa0 * a4[1] + wa1 * a4[2] + wa2 * a4[3] + ba;
          av[3] = wa0 * a4[2] + wa1 * a4[3] + wa2 * ap + ba;
          gv[0] = wg0 * gm + wg1 * g4[0] + wg2 * g4[1] + bgv;
          gv[1] = wg0 * g4[0] + wg1 * g4[1] + wg2 * g4[2] + bgv;
          gv[2] = wg0 * g4[1] + wg1 * g4[2] + wg2 * g4[3] + bgv;
          gv[3] = wg0 * g4[2] + wg1 * g4[3] + wg2 * gp + bgv;
#pragma unroll
          for (int e = 0; e < 4; e++) {
            const int r = r0 + e;
            const int s = sfirst + r;
            if (r >= 1 && r <= 126 && s >= seg_lo && s < seg_hi) actb[(size_t)s * FF] = f2bf(silu_f(gv[e]) * av[e]);
          }
        }
        }
      }
    }
    }
    }
#endif
    xcd_barrier(xbar);

#ifndef SKIP_P11
    {
    {
    const int tid = opaque_tid(), lane = tid & 63, w = tid >> 6, l15 = lane & 15, quad = lane >> 4;
    const int wm = w >> 1, wn = w & 1;
    (void)wm; (void)wn; (void)l15; (void)quad;
    {
    const int nwide = 256 * 4;
    const int total_items = nwide + (last ? 0 : 64);
    for (int it = vb; it < total_items; it += G) {
      if (it < nwide) {
        const int mi = it >> 2, nt = it & 3;
        const int mt = (mi >> 6) * 66 + 2 + (mi & 63);
        const int m0 = mt * 128, n0 = nt * 256;
        const int b = m0 / SS;
        f32x4 acc[4][8];
        gemm_wide([&](int r) { return (const u16*)(ACT + (size_t)(m0 + r) * FF); },
                  [&](int n) { return (const u16*)(W + OW_DOWN + (size_t)(n0 + n) * FF); }, 88, acc, ldsu);
        const int tid = opaque_tid(), lane = tid & 63, w = tid >> 6, l15 = lane & 15, quad = lane >> 4, wm = w >> 1, wn = w & 1; (void)lane; (void)wm; (void)wn; (void)l15; (void)quad;
        const float* g2 = modl + (size_t)b * 6144 + 5 * 1024;

        float* xo = xrow(xout, m0) + n0;
        asm volatile("" ::: "memory");
#pragma unroll
        for (int jh = 0; jh < 4; jh++) {
          float xv[2][4][4];
#pragma unroll
          for (int j = 0; j < 2; j++)
#pragma unroll
            for (int i = 0; i < 4; i++)
#pragma unroll
              for (int e = 0; e < 4; e++) xv[j][i][e] = xo[ACC_ROW(i, e) * 1024 + ACC_COLW(jh * 2 + j)];
#pragma unroll
          for (int j = 0; j < 2; j++) {
            const float gv = g2[n0 + ACC_COLW(jh * 2 + j)];
#pragma unroll
            for (int i = 0; i < 4; i++)
#pragma unroll
              for (int e = 0; e < 4; e++) xo[ACC_ROW(i, e) * 1024 + ACC_COLW(jh * 2 + j)] = xv[j][i][e] + gv * acc[i][jh * 2 + j][e];
          }
        }
        continue;
      }
      const int jc = it - nwide;
      const int mc = jc >> 3, nt = jc & 7;
      const int mt = (mc >> 1) * 66 + (mc & 1);
      const int m0 = mt * 128, n0 = nt * 128;
      const int b = m0 / SS, s0 = m0 - b * SS;
      const int mrow = (s0 < CC) ? 4 : b;
      f32x4 acc[4][4];
      gemm_core<128>([&](int r) { return (const u16*)(ACT + (size_t)(m0 + r) * FF); },
                     [&](int n) { return (const u16*)(W + OW_DOWN + (size_t)(n0 + n) * FF); }, 44, acc, ldsu);
      const int tid = opaque_tid(), lane = tid & 63, w = tid >> 6, l15 = lane & 15, quad = lane >> 4, wm = w >> 1, wn = w & 1; (void)lane; (void)wm; (void)wn; (void)l15; (void)quad;
      const float* g2 = modl + (size_t)mrow * 6144 + 5 * 1024;
      float* xo = xrow(xout, m0) + n0;
      asm volatile("" ::: "memory");
#pragma unroll
      for (int jh = 0; jh < 2; jh++) {
        float xv[2][4][4];
#pragma unroll
        for (int j = 0; j < 2; j++)
#pragma unroll
          for (int i = 0; i < 4; i++)
#pragma unroll
            for (int e = 0; e < 4; e++) xv[j][i][e] = xo[ACC_ROW(i, e) * 1024 + ACC_COL(128, jh * 2 + j)];
#pragma unroll
        for (int j = 0; j < 2; j++) {
          const float gv = g2[n0 + ACC_COL(128, jh * 2 + j)];
#pragma unroll
          for (int i = 0; i < 4; i++)
#pragma unroll
            for (int e = 0; e < 4; e++) xo[ACC_ROW(i, e) * 1024 + ACC_COL(128, jh * 2 + j)] = xv[j][i][e] + gv * acc[i][jh * 2 + j][e];
        }
      }
    }
    }
    }
    }
#endif
  }
}

extern "C" void kernel_launch(void* const* d_in, const int* in_sizes, int n_in, void* d_out, int out_size,
                              void* d_ws, size_t ws_size, hipStream_t stream) {
  static int grid_blocks = 0;
  if (!grid_blocks) {
    int dev = 0, cus = 0, per_cu = 0;
    (void)hipGetDevice(&dev);
    (void)hipDeviceGetAttribute(&cus, hipDeviceAttributeMultiprocessorCount, dev);
    (void)hipOccupancyMaxActiveBlocksPerMultiprocessor(&per_cu, fwd_megakernel, 256, 0);
    if (per_cu > 2) per_cu = 2;
    if (per_cu < 1) per_cu = 1;
    grid_blocks = cus * per_cu;
    if (ws_size < WS_END) fprintf(stderr, "workspace too small: %zu < %zu\n", ws_size, (size_t)WS_END);
  }
  Params p{};
  for (int i = 0; i < 29; i++) p.in[i] = (const float*)d_in[i];
  p.out = (float*)d_out;
  p.ws = (char*)d_ws;
  p.pad = 0;
  (void)hipMemsetAsync((char*)d_ws + WS_BAR, 0, 3456 * 4, stream);
  void* args[] = {&p};
  hipError_t e = hipLaunchCooperativeKernel((void*)fwd_megakernel, dim3(grid_blocks), dim3(256), args, 0, stream);
  if (e != hipSuccess) fprintf(stderr, "cooperative launch failed: %s (grid %d)\n", hipGetErrorString(e), grid_blocks);
}
```
